# Optimizing an MI355X kernel written in HIP

```python
import jax, jax.numpy as jnp
from jax import lax
import numpy as np

D_MODEL = 2048
BATCH = 8
SEQ = 2048
DEPTH = 1

CHUNK = 64
EPS = 1e-6

N_HEADS_A = 16
HEAD_DIM_A = 128
V_DIM_A = 128
KV_LATENT = 256
N_HEADS_IDX = 16
IDX_DIM = 128
TOPK_KEYS_MAX = 256
Q_BLOCK = 128
ATTN_SCALE = HEAD_DIM_A ** -0.5
IDX_W_SCALE = (N_HEADS_IDX ** -0.5) * (IDX_DIM ** -0.5)

SG_CHUNK = 128
N_GROUPS_B = 8
WIDTH_B = 2048
GROUP_DIM_B = WIDTH_B // N_GROUPS_B

N_EXPERTS = 32
TOP_K = 4
D_FF = 2048
SWIGLU_ALPHA = 1.702
SWIGLU_LIMIT = 7.0
MOE_BLOCK = 128

W_QA = N_HEADS_A * HEAD_DIM_A
W_QIDX = N_HEADS_IDX * IDX_DIM
SPLIT_POINTS = [
    W_QA,
    W_QA + KV_LATENT,
    W_QA + KV_LATENT + W_QIDX,
    W_QA + KV_LATENT + W_QIDX + IDX_DIM,
    W_QA + KV_LATENT + W_QIDX + IDX_DIM + N_HEADS_IDX,
    W_QA + KV_LATENT + W_QIDX + IDX_DIM + N_HEADS_IDX + 2 * WIDTH_B,
]
N_IN = SPLIT_POINTS[-1] + 2 * D_MODEL

kernel_name = "hybrid_dsa_gmlp_moe_adaln_block"


def rms_norm(x, g):
    xf = x.astype(jnp.float32)
    y = xf * lax.rsqrt(jnp.mean(xf * xf, axis=-1, keepdims=True) + EPS)
    return (y * g.astype(jnp.float32)).astype(x.dtype)


def layer_norm(x, g):
    xf = x.astype(jnp.float32)
    mu = jnp.mean(xf, axis=-1, keepdims=True)
    var = jnp.mean(jnp.square(xf - mu), axis=-1, keepdims=True)
    return ((xf - mu) * lax.rsqrt(var + EPS) * g.astype(jnp.float32)).astype(x.dtype)


def dsa_mla_attention(q_lat, c_kv, q_idx, k_idx, w_idx):
    B, S, H, C = q_lat.shape
    k_sel = min(TOPK_KEYS_MAX, S // 4)
    n_blk = S // Q_BLOCK
    key_chunk = jnp.arange(S) // CHUNK

    def to_blocks(a):
        return jnp.moveaxis(a.reshape((B, n_blk, Q_BLOCK) + a.shape[2:]), 1, 0)

    def one_block(args):
        blk, ql, qi, wi = args
        q_chunk = (blk * Q_BLOCK + jnp.arange(Q_BLOCK)) // CHUNK
        allowed = key_chunk[None, :] <= q_chunk[:, None]
        logits = jnp.einsum('bqhd,bsd->bqhs', qi, k_idx)
        idx_score = jnp.einsum('bqhs,bqh->bqs', jax.nn.relu(logits), wi).astype(jnp.float32)
        idx_score = jnp.where(allowed[None], idx_score, -jnp.inf)
        _, sel = lax.top_k(idx_score, k_sel)
        valid = key_chunk[sel] <= q_chunk[None, :, None]
        c_sel = jax.vmap(lambda c, i: c[i])(c_kv, sel)
        s = jnp.einsum('bqhc,bqkc->bqhk', ql, c_sel).astype(jnp.float32) * ATTN_SCALE
        s = jnp.where(valid[:, :, None, :], s, -jnp.inf)
        p = jax.nn.softmax(s, axis=-1).astype(c_sel.dtype)
        return jnp.einsum('bqhk,bqkc->bqhc', p, c_sel)

    o = lax.map(one_block, (jnp.arange(n_blk), to_blocks(q_lat), to_blocks(q_idx), to_blocks(w_idx)))
    return jnp.moveaxis(o, 0, 1).reshape(B, S, H, C)


def spatial_gating(z, ln_g, w_s, b_s):
    u, v = jnp.split(z, 2, axis=-1)
    v = layer_norm(v, ln_g)
    B, S, _ = v.shape
    v = v.reshape(B, S // SG_CHUNK, SG_CHUNK, N_GROUPS_B, GROUP_DIM_B)
    causal = jnp.tril(jnp.ones((SG_CHUNK, SG_CHUNK), dtype=w_s.dtype))
    w = w_s * causal[None]
    s = jnp.einsum('gts,bnsgd->bntgd', w, v) + jnp.transpose(b_s)[:, :, None]
    return u * s.reshape(B, S, WIDTH_B)


def clamped_swiglu(h):
    g = jnp.minimum(h[:, :D_FF], SWIGLU_LIMIT)
    lin = jnp.clip(h[:, D_FF:], -SWIGLU_LIMIT, SWIGLU_LIMIT)
    return g * jax.nn.sigmoid(SWIGLU_ALPHA * g) * (lin + 1.0)


def moe_ffn(xn, w_router, b_router, w_gate_up, b_gate_up, w_down, b_down):
    B, S, D = xn.shape
    T = B * S
    xf = xn.reshape(T, D)
    logits = (xf @ w_router + b_router).astype(jnp.float32)
    top_vals, top_idx = lax.top_k(logits, TOP_K)
    gates = jax.nn.softmax(top_vals, axis=-1).astype(xn.dtype)

    TK = T * TOP_K
    P = TK + N_EXPERTS * MOE_BLOCK
    n_blk = P // MOE_BLOCK
    flat_e = top_idx.reshape(-1)
    flat_tok = jnp.repeat(jnp.arange(T, dtype=jnp.int32), TOP_K)
    flat_g = gates.reshape(-1)
    order = jnp.argsort(flat_e)
    sorted_e = flat_e[order]
    counts = jnp.bincount(flat_e, length=N_EXPERTS)
    padded = ((counts + MOE_BLOCK - 1) // MOE_BLOCK) * MOE_BLOCK
    starts = jnp.cumsum(counts) - counts
    pad_ends = jnp.cumsum(padded)
    pstarts = pad_ends - padded
    dest = pstarts[sorted_e] + jnp.arange(TK) - starts[sorted_e]
    row_tok = jnp.zeros((P,), jnp.int32).at[dest].set(flat_tok[order])
    row_gate = jnp.zeros((P,), xn.dtype).at[dest].set(flat_g[order])
    block_e = jnp.clip(jnp.searchsorted(pad_ends, jnp.arange(n_blk) * MOE_BLOCK, side='right'),
                       0, N_EXPERTS - 1)

    def one_block(args):
        tok, g, e = args
        xb = xf[tok]
        h = xb @ w_gate_up[e] + b_gate_up[e]
        y = clamped_swiglu(h) @ w_down[e] + b_down[e]
        return y * g[:, None]

    ys = lax.map(one_block, (row_tok.reshape(n_blk, MOE_BLOCK), row_gate.reshape(n_blk, MOE_BLOCK), block_e))
    out = jnp.zeros((T, D), xn.dtype).at[row_tok].add(ys.reshape(P, D))
    return out.reshape(B, S, D)


def setup_inputs(seed: int = 0) -> dict:
    key = jax.random.key(seed)
    ks = jax.random.split(key, 32)
    f32 = jnp.float32

    def nrm(k, shape, scale):
        return jax.random.normal(k, shape, f32) * scale

    D, L = D_MODEL, DEPTH
    return {
        "x": nrm(ks[0], (BATCH, SEQ, D), 1.0),
        "c": nrm(ks[1], (BATCH, D), 1.0),
        "w_mod": nrm(ks[2], (L, D, 6 * D), 0.1 * D ** -0.5),
        "b_mod": nrm(ks[3], (L, 6 * D), 0.01),
        "norm1_g": 1.0 + nrm(ks[4], (L, D), 0.1),
        "w_in": nrm(ks[5], (L, D, N_IN), D ** -0.5),
        "kv_norm_g": 1.0 + nrm(ks[6], (L, KV_LATENT), 0.1),
        "w_uk": nrm(ks[7], (L, N_HEADS_A, HEAD_DIM_A, KV_LATENT), HEAD_DIM_A ** -0.5),
        "w_uv": nrm(ks[8], (L, N_HEADS_A, KV_LATENT, V_DIM_A), KV_LATENT ** -0.5),
        "w_proj_a": nrm(ks[9], (L, N_HEADS_A * V_DIM_A, D), (N_HEADS_A * V_DIM_A) ** -0.5),
        "sg_norm_g": 1.0 + nrm(ks[10], (L, WIDTH_B), 0.1),
        "w_spatial": nrm(ks[11], (L, N_GROUPS_B, SG_CHUNK, SG_CHUNK), SG_CHUNK ** -0.5),
        "b_spatial": nrm(ks[12], (L, N_GROUPS_B, SG_CHUNK), 0.02),
        "w_proj_b": nrm(ks[13], (L, WIDTH_B, D), WIDTH_B ** -0.5),
        "w_out": nrm(ks[14], (L, D, D), D ** -0.5),
        "norm2_g": 1.0 + nrm(ks[15], (L, D), 0.1),
        "w_router": nrm(ks[16], (L, D, N_EXPERTS), D ** -0.5),
        "b_router": nrm(ks[17], (L, N_EXPERTS), 0.01),
        "w_gate_up": nrm(ks[18], (L, N_EXPERTS, D, 2 * D_FF), D ** -0.5),
        "b_gate_up": nrm(ks[19], (L, N_EXPERTS, 2 * D_FF), 0.01),
        "w_down": nrm(ks[20], (L, N_EXPERTS, D_FF, D), D_FF ** -0.5),
        "b_down": nrm(ks[21], (L, N_EXPERTS, D), 0.01),
        "final_g": 1.0 + nrm(ks[22], (D,), 0.1),
    }


def reference(x, c, w_mod, b_mod, norm1_g, w_in, kv_norm_g, w_uk, w_uv, w_proj_a,
              sg_norm_g, w_spatial, b_spatial, w_proj_b, w_out, norm2_g,
              w_router, b_router, w_gate_up, b_gate_up, w_down, b_down, final_g):
    B, S, D = x.shape
    c_act = jax.nn.silu(c)
    for l in range(DEPTH):
        mod = c_act @ w_mod[l] + b_mod[l]
        sh1, sc1, g1, sh2, sc2, g2 = [m[:, None, :] for m in jnp.split(mod, 6, axis=-1)]

        h = rms_norm(x, norm1_g[l]) * (1.0 + sc1) + sh1
        proj = h @ w_in[l]
        q_a, c_kv, q_idx, k_idx, w_idx, z_b, gate_pre = jnp.split(proj, SPLIT_POINTS, axis=-1)

        q_a = q_a.reshape(B, S, N_HEADS_A, HEAD_DIM_A)
        c_kv = rms_norm(c_kv, kv_norm_g[l])
        q_lat = jnp.einsum('bshd,hdc->bshc', q_a, w_uk[l])
        q_idx = q_idx.reshape(B, S, N_HEADS_IDX, IDX_DIM)
        o_lat = dsa_mla_attention(q_lat, c_kv, q_idx, k_idx, w_idx * IDX_W_SCALE)
        o_a = jnp.einsum('bshc,hcv->bshv', o_lat, w_uv[l]).reshape(B, S, N_HEADS_A * V_DIM_A)
        y_a = o_a @ w_proj_a[l]

        sg = spatial_gating(jax.nn.gelu(z_b, approximate=False), sg_norm_g[l], w_spatial[l], b_spatial[l])
        y_b = sg @ w_proj_b[l]

        gate_a, gate_b = jnp.split(jax.nn.sigmoid(gate_pre), 2, axis=-1)
        mix = (gate_a * y_a + gate_b * y_b) @ w_out[l]
        x = x + g1 * mix

        h2 = rms_norm(x, norm2_g[l]) * (1.0 + sc2) + sh2
        x = x + g2 * moe_ffn(h2, w_router[l], b_router[l], w_gate_up[l], b_gate_up[l], w_down[l], b_down[l])
    return rms_norm(x, final_g)
```

```cpp
#include <hip/hip_runtime.h>
#include <cstdio>
#include <cstdint>

#ifndef MK_N_LAUNCHES
#define MK_N_LAUNCHES 1
#endif
#ifndef MK_STAGE
#define MK_STAGE 9
#endif

#define GAS __attribute__((address_space(1)))
#define LAS __attribute__((address_space(3)))
typedef unsigned short bf16;
typedef short bf16x8 __attribute__((ext_vector_type(8)));
typedef short s16x4 __attribute__((ext_vector_type(4)));
typedef float f32x2 __attribute__((ext_vector_type(2)));
typedef float f32x4 __attribute__((ext_vector_type(4)));
typedef float f32x16 __attribute__((ext_vector_type(16)));
typedef unsigned u32x2 __attribute__((ext_vector_type(2)));
typedef unsigned u32x4 __attribute__((ext_vector_type(4)));
typedef GAS unsigned gu32;
typedef int i32x8 __attribute__((ext_vector_type(8)));
constexpr float W8_SCALE = 32.0f, W8_INV = 1.0f / 32.0f;
__device__ __forceinline__ unsigned cvt4_fp8(float a, float b, float c, float d) { int w = 0; w = __builtin_amdgcn_cvt_pk_fp8_f32(a, b, w, false); w = __builtin_amdgcn_cvt_pk_fp8_f32(c, d, w, true); return (unsigned)w; }
#define RLX_AGENT __ATOMIC_RELAXED, __HIP_MEMORY_SCOPE_AGENT
#define LDS_WAIT() asm volatile("s_waitcnt lgkmcnt(0)" ::: "memory")
#define VM_WAIT() asm volatile("s_waitcnt vmcnt(0)" ::: "memory")
#define LDS_BARRIER() do { asm volatile("s_waitcnt lgkmcnt(0)" ::: "memory"); __builtin_amdgcn_s_barrier(); asm volatile("" ::: "memory"); } while (0)

constexpr int D = 2048, NB = 8, SEQ = 2048, T = NB * SEQ;
constexpr int NIN_SRC = 12688, NIN = 12800;
constexpr int NIN_A = 2304, NIN_B = 10496;
constexpr int NE = 32, TOPK = 4, DFF = 2048;
constexpr int PMAX = T * TOPK + NE * 256;
constexpr int MT_MAX = PMAX / 256;
constexpr int KC = 8;
constexpr float EPS = 1e-6f;
constexpr float IDX_W_SCALE = 0.25f * 0.08838834764831845f;
constexpr int KSEL = 256;

constexpr size_t MiB = 1u << 20;
constexpr size_t WS_CTL = 0, CTL_ZERO_BYTES = 1 * MiB;
constexpr size_t WS_MODP = 1 * MiB;
constexpr size_t WS_MODF = 13 * MiB;
constexpr size_t WS_WKV = 14 * MiB;
constexpr size_t WS_WSP = 16 * MiB;
constexpr size_t WS_WRT = 17 * MiB;
constexpr size_t WS_SSQ = 18 * MiB;
constexpr size_t WS_WI = 19 * MiB;
constexpr size_t WS_KI = 20 * MiB;
constexpr size_t WS_MASK = 24 * MiB;
constexpr size_t WS_ROUTE = 28 * MiB;
constexpr size_t WS_CKV = 30 * MiB;
constexpr size_t WS_WPA = 40 * MiB, WS_WPB = 48 * MiB, WS_WOUT = 56 * MiB;
constexpr size_t WS_WIN = 64 * MiB;
constexpr size_t WS_WIN8 = 96 * MiB;
constexpr size_t WS_H2F8 = 2176 * MiB;
constexpr size_t WS_H1F8 = 2176 * MiB;
constexpr size_t WS_H1 = 128 * MiB;
constexpr size_t WS_Q = 192 * MiB, WS_QI = 256 * MiB, WS_U = 320 * MiB, WS_V = 384 * MiB, WS_GA = 448 * MiB, WS_GB = 512 * MiB;
constexpr size_t WS_KH = 576 * MiB, WS_VH = 640 * MiB, WS_VST = 704 * MiB  , WS_SG = 768 * MiB, WS_OA = 832 * MiB, WS_YB = 896 * MiB, WS_MIX = 960 * MiB;
constexpr size_t WS_H2 = 1024 * MiB, WS_H2LO = 1088 * MiB;
constexpr size_t WS_SC = 1152 * MiB;
constexpr size_t WS_X1 = 1280 * MiB;
constexpr size_t WS_WGU = 1408 * MiB;
constexpr size_t WS_WD = 1920 * MiB;
constexpr size_t WS_XG = 2176 * MiB, WS_ACT = 2464 * MiB, WS_YS = 2752 * MiB;
constexpr size_t WS_END = 3040 * MiB;
constexpr size_t RT_TOPE = 0, RT_TOPG = 256 * 1024, RT_POS = 512 * 1024, RT_HIST = 768 * 1024, RT_TILE = 832 * 1024, RT_NMT = 896 * 1024, RT_GATE = 1024 * 1024, RT_TOK = 1536 * 1024;
constexpr int CW_BAR = 4096;

constexpr int RING_BYTES = 147456;
constexpr int LDSCTL_OFF = RING_BYTES, MISC_OFF = LDSCTL_OFF + 320;
constexpr int LDS_BYTES = 155648;
constexpr int NWAVES = 8;

__device__ __forceinline__ unsigned cvtpk(float lo, float hi) { unsigned r; asm volatile("v_cvt_pk_bf16_f32 %0, %1, %2" : "=v"(r) : "v"(lo), "v"(hi)); return r; }
__device__ __forceinline__ void gload_x4_untracked(f32x4& dst, const float* p) { asm volatile("global_load_dwordx4 %0, %1, off" : "=v"(dst) : "v"(p) : "memory"); }
__device__ __forceinline__ void gload_x1_untracked(float& dst, const float* p) { asm volatile("global_load_dword %0, %1, off" : "=v"(dst) : "v"(p) : "memory"); }
__device__ __forceinline__ float bf2f(unsigned short h) { return __builtin_bit_cast(float, (unsigned)h << 16); }
__device__ __forceinline__ float bflo(unsigned w) { return __builtin_bit_cast(float, w << 16); }
__device__ __forceinline__ float bfhi(unsigned w) { return __builtin_bit_cast(float, w & 0xffff0000u); }
__device__ __forceinline__ float wave_sum(float v) {
#pragma unroll
    for (int o = 1; o < 64; o <<= 1) v += __shfl_xor(v, o);
    return v;
}
__device__ __forceinline__ float sigmoidf_(float x) { return __builtin_amdgcn_rcpf(1.0f + __builtin_amdgcn_exp2f(-1.4426950408889634f * x)); }
__device__ __forceinline__ f32x2 gelu_pk(f32x2 v) {
    const f32x2 av = __builtin_elementwise_abs(v), d = av * 0.2316418882f + 1.0f;
    f32x2 t; t.x = __builtin_amdgcn_rcpf(d.x); t.y = __builtin_amdgcn_rcpf(d.y);
    f32x2 q = t * 0.5307027145f + (-0.7265760135f); q = q * t + 0.7107068705f; q = q * t + (-0.142248368f); q = q * t + 0.127414796f; q = q * t;
    const f32x2 s = (v * v) * (-0.72134752044f);
    f32x2 e; e.x = __builtin_amdgcn_exp2f(s.x); e.y = __builtin_amdgcn_exp2f(s.y);
    const f32x2 m = v * (q * e), r = v - m;
    f32x2 o; o.x = v.x < 0.f ? m.x : r.x; o.y = v.y < 0.f ? m.y : r.y; return o;
}

namespace pg8 {
constexpr int BM = 256, BK = 64, HALF = 128, HTB = HALF * BK * 2, STAGE_BYTES = 8 * HTB, NXCD = 8, WGM = 4;
__host__ __device__ __forceinline__ int lds_byte(int r, int c) { const int st = (r >> 4) * 2 + (c >> 5), rr = r & 15, cc = c & 31, ob = rr * 64 + cc * 2; return st * 1024 + (ob ^ (((ob >> 9) & 1) << 5)); }
__host__ __device__ __forceinline__ void stage_rc(int b, int& R, int& C) { const int st = b / 1024, sb = b % 1024, swz = sb ^ (((sb >> 9) & 1) << 5); R = (st >> 1) * 16 + swz / 64; C = (st & 1) * 32 + (swz % 64) / 2; }
__host__ __device__ __forceinline__ int perm32(int rho) { const int n = rho >> 4, i = rho & 15; return 8 * (i >> 2) + 4 * n + (i & 3); }

struct Unit { int pm, pn, pb, e; };
struct Gemm { const bf16* A; const bf16* Bt; int K; };
template <class S, class = void> struct SchedGather { static constexpr bool v = false; };
template <class S> struct SchedGather<S, decltype((void)S::GATHER)> { static constexpr bool v = S::GATHER; };

struct StaticOrder {
    int nM, nN, nwg, G, c;
    __device__ void init(int M, int N, int G_, int c_) { nM = M / BM; nN = N / BM; nwg = nM * nN; G = G_; c = c_; }
    __device__ bool next(int i, Unit& u) const {
        const long L = (long)i * G + c; if (L >= nwg) return false;
        int wgid = (int)L; { const int q = nwg / NXCD, r = nwg % NXCD, xcd = wgid % NXCD, off = wgid / NXCD; wgid = (xcd < r ? xcd * (q + 1) : r * (q + 1) + (xcd - r) * q) + off; }
        const int nig = WGM * nN, gid = wgid / nig, fm = gid * WGM, gsz = (nM - fm) < WGM ? (nM - fm) : WGM;
        u.pm = fm + ((wgid % nig) % gsz); u.pn = (wgid % nig) / gsz; u.pb = u.pn; u.e = 0; return true;
    }
};
struct UnevenOrder {
    static constexpr int FR = 9, XR = 2, C0 = 64;
    StaticOrder so; bool uneven;
    __device__ void init(int M, int N, int G_, int c_) { so.init(M, N, G_, c_); uneven = (G_ == 256 && so.nwg % NXCD == 0 && so.nwg >= FR * 256 && so.nwg <= FR * 256 + XR * (256 - C0)); }
    __device__ bool next(int i, Unit& u) const {
        if (!uneven) return so.next(i, u);
        long L;
        if (i < FR) L = (long)i * 256 + so.c; else { if (so.c < C0 || i >= FR + XR) return false; L = FR * 256 + (long)(i - FR) * (256 - C0) + (so.c - C0); if (L >= so.nwg) return false; }
        int wgid = (int)L; { const int q = so.nwg / NXCD, xcd = wgid % NXCD, off = wgid / NXCD; wgid = xcd * q + off; }
        const int nig = WGM * so.nN, gid = wgid / nig, fm = gid * WGM, gsz = (so.nM - fm) < WGM ? (so.nM - fm) : WGM;
        u.pm = fm + ((wgid % nig) % gsz); u.pn = (wgid % nig) / gsz; u.pb = u.pn; u.e = 0; return true;
    }
};
struct MoeOrder {
    int nM, nN, nwg, G, c; const LAS int* tile_e;
    __device__ void init(int nM_, int nN_, int G_, int c_, const LAS int* te) { nM = nM_; nN = nN_; nwg = nM * nN; G = G_; c = c_; tile_e = te; }
    __device__ bool next(int i, Unit& u) const {
        const long L = (long)i * G + c; if (L >= nwg) return false;
        int wgid = (int)L; { const int q = nwg / NXCD, r = nwg % NXCD, xcd = wgid % NXCD, off = wgid / NXCD; wgid = (xcd < r ? xcd * (q + 1) : r * (q + 1) + (xcd - r) * q) + off; }
        const int nig = WGM * nN, gid = wgid / nig, fm = gid * WGM, gsz = (nM - fm) < WGM ? (nM - fm) : WGM;
        u.pm = fm + ((wgid % nig) % gsz); u.pn = (wgid % nig) / gsz; u.e = __builtin_amdgcn_readfirstlane(tile_e[u.pm]); u.pb = u.e * nN + u.pn; return true;
    }
};

struct MoeGatherOrder : MoeOrder { static constexpr bool GATHER = true; const int* rowtok; };
template <class Epi, class Sched, bool F8 = false, bool ALIGN_EPI = true>
__device__ __forceinline__ void gemm_phase(LAS unsigned char* lds, const Gemm g, const Sched& S, const Epi& E) {
    const int tid = threadIdx.x, wid = __builtin_amdgcn_readfirstlane(tid >> 6), lane = tid & 63, wr = wid >> 2, wc = wid & 3, fr = lane & 15, fq = lane >> 4;
    const int K = F8 ? g.K / 2 : g.K, nt = K / BK;
    constexpr bool GA = SchedGather<Sched>::v;
    unsigned voffA[2], voffB[2]; int Rr[2]; unsigned cofs[2];
#pragma unroll
    for (int i = 0; i < 2; ++i) { int R, C; stage_rc(tid * 16 + i * 8192, R, C); const int Rb = Epi::PERM ? ((R & ~31) + perm32(R & 31)) : R;
        voffA[i] = (unsigned)(R * K + C) * 2u; voffB[i] = (unsigned)(Rb * K + C) * 2u; Rr[i] = R; cofs[i] = (unsigned)C * 2u; }
    unsigned gC[2][2], gN[2][2]; int tokN[2][2];
    const size_t kstep = (size_t)(BK * 2);
    const size_t hstep = (size_t)HALF * K * 2;
    const size_t tstep = 2 * hstep;
    const unsigned ldsw = (unsigned)wid * 1024u;
    const int aoff = lds_byte(wr * 64 + fr, fq * 8), boff = lds_byte(wc * 32 + fr, fq * 8);
#define PG8_SA(b, h) (((b) * 2 + (h)) * HTB)
#define PG8_SB(b, h) ((4 + (b) * 2 + (h)) * HTB)
#define PG8_STAGE(bufoff, gbase, voff) do { _Pragma("unroll") for (int _i = 0; _i < 2; ++_i) \
        __builtin_amdgcn_global_load_lds((const unsigned*)((const char*)(gbase) + (voff)[_i]), (LAS unsigned*)(lds + (bufoff) + ldsw + _i * 8192), 16, 0, 0); } while (0)
#define PG8_STAGE_A(bufoff, kb, h, NX) do { if constexpr (GA) { _Pragma("unroll") for (int _i = 0; _i < 2; ++_i) { const unsigned vo_ = (NX) ? gN[h][_i] : gC[h][_i]; \
        __builtin_amdgcn_global_load_lds((const unsigned*)((const char*)(kb) + vo_), (LAS unsigned*)(lds + (bufoff) + ldsw + _i * 8192), 16, 0, 0); } } else PG8_STAGE(bufoff, (kb) + ((h) ? hstep : 0), voffA); } while (0)
#define PG8_LD8(p_) ({ const u32x4 lo_ = *(const LAS u32x4*)(p_), hi_ = *(const LAS u32x4*)((p_) + 1024); (i32x8){(int)lo_.x, (int)lo_.y, (int)lo_.z, (int)lo_.w, (int)hi_.x, (int)hi_.y, (int)hi_.z, (int)hi_.w}; })
#define PG8_LDA(dst, b, h) do { if constexpr (F8) { _Pragma("unroll") for (int m = 0; m < 4; ++m) dst##8[m] = PG8_LD8(lds + PG8_SA(b, h) + aoff + m * 2048); } else { \
        _Pragma("unroll") for (int m = 0; m < 4; ++m) _Pragma("unroll") for (int k = 0; k < 2; ++k) dst[m][k] = *(const LAS bf16x8*)(lds + PG8_SA(b, h) + aoff + m * 2048 + k * 1024); } } while (0)
#define PG8_LDB(dst, b, h) do { if constexpr (F8) { _Pragma("unroll") for (int n = 0; n < 2; ++n) dst##8[n] = PG8_LD8(lds + PG8_SB(b, h) + boff + n * 2048); } else { \
        _Pragma("unroll") for (int n = 0; n < 2; ++n) _Pragma("unroll") for (int k = 0; k < 2; ++k) dst[n][k] = *(const LAS bf16x8*)(lds + PG8_SB(b, h) + boff + n * 2048 + k * 1024); } } while (0)
#define PG8_MMA(ai, bj, At, Bt) do { __builtin_amdgcn_s_setprio(1); if constexpr (F8) { _Pragma("unroll") for (int m = 0; m < 4; ++m) _Pragma("unroll") for (int n = 0; n < 2; ++n) \
        asm volatile("v_mfma_f32_16x16x128_f8f6f4 %0, %1, %2, %0" : "+v"(acc[ai][bj][m][n]) : "v"(Bt##8[n]), "v"(At##8[m])); } else { \
        _Pragma("unroll") for (int m = 0; m < 4; ++m) _Pragma("unroll") for (int n = 0; n < 2; ++n) _Pragma("unroll") for (int k = 0; k < 2; ++k) \
        acc[ai][bj][m][n] = __builtin_amdgcn_mfma_f32_16x16x32_bf16(Bt[n][k], At[m][k], acc[ai][bj][m][n], 0, 0, 0); } __builtin_amdgcn_s_setprio(0); } while (0)
#define PG8_WAIT_V(n) asm volatile("s_waitcnt vmcnt(" #n ")" ::: "memory")
#define PG8_WAIT_V8L() do { if (Epi::HAS_PRE && last) asm volatile("s_waitcnt vmcnt(%0)" :: "i"(8 + Epi::NPRE) : "memory"); else asm volatile("s_waitcnt vmcnt(8)" ::: "memory"); } while (0)
#define PG8_WAIT_L(n) asm volatile("s_waitcnt lgkmcnt(" #n ")" ::: "memory")
#define PG8_BAR __builtin_amdgcn_s_barrier()
#define PG8_SCHED __builtin_amdgcn_sched_barrier(0)
    Unit cur, nxt; int ui = 0;
    if (!S.next(0, cur)) return;
    f32x4 acc[2][2][4][2];
#pragma unroll
    for (int a = 0; a < 2; ++a)
#pragma unroll
        for (int b = 0; b < 2; ++b)
#pragma unroll
            for (int m = 0; m < 4; ++m)
#pragma unroll
                for (int n = 0; n < 2; ++n) acc[a][b][m][n] = (f32x4){0.f, 0.f, 0.f, 0.f};
    typename Epi::Pre epre;
    bf16x8 At[4][2], B0[2][2], B1[2][2]; i32x8 At8[4], B08[2], B18[2];
    const char* cA = GA ? (const char*)g.A : (const char*)g.A + (size_t)cur.pm * tstep; const char* cB = (const char*)g.Bt + (size_t)cur.pb * tstep;
    if constexpr (GA) {
#pragma unroll
        for (int h = 0; h < 2; ++h)
#pragma unroll
            for (int i = 0; i < 2; ++i) { gC[h][i] = (unsigned)S.rowtok[cur.pm * BM + h * HALF + Rr[i]] * (unsigned)(K * 2) + cofs[i]; gN[h][i] = gC[h][i]; tokN[h][i] = 0; } }
    PG8_STAGE(PG8_SB(0, 0), cB, voffB); PG8_STAGE(PG8_SB(0, 1), cB + hstep, voffB); PG8_STAGE_A(PG8_SA(0, 0), cA, 0, false); PG8_STAGE_A(PG8_SA(0, 1), cA, 1, false);
    if (wr == 1) PG8_BAR;
    PG8_WAIT_V(2); PG8_BAR;
    PG8_STAGE(PG8_SB(1, 0), cB + kstep, voffB); PG8_STAGE_A(PG8_SA(1, 0), cA + kstep, 0, false); PG8_STAGE(PG8_SB(1, 1), cB + hstep + kstep, voffB);
    PG8_WAIT_V(6); PG8_BAR;
    for (;;) {
        const bool has_next = S.next(ui + 1, nxt);
        const char* nA = GA ? cA : (has_next ? (const char*)g.A + (size_t)nxt.pm * tstep : cA); const char* nB = has_next ? (const char*)g.Bt + (size_t)nxt.pb * tstep : cB;
        if constexpr (GA) { if (has_next) {
#pragma unroll
            for (int h = 0; h < 2; ++h)
#pragma unroll
                for (int i = 0; i < 2; ++i) asm volatile("global_load_dword %0, %1, off" : "=v"(tokN[h][i]) : "v"(S.rowtok + nxt.pm * BM + h * HALF + Rr[i]) : "memory"); } }
        for (int t = 0; t < nt; t += 2) {
            const bool last = (t == nt - 2);
            if constexpr (GA) { if (last && has_next) {
#pragma unroll
                for (int h = 0; h < 2; ++h)
#pragma unroll
                    for (int i = 0; i < 2; ++i) { asm volatile("" : "+v"(tokN[h][i])); gN[h][i] = (unsigned)tokN[h][i] * (unsigned)(K * 2) + cofs[i]; } } }
            if constexpr (Epi::HAS_PRE) { if (last) { int lp_; asm volatile("v_mbcnt_lo_u32_b32 %0, -1, 0\n\tv_mbcnt_hi_u32_b32 %0, -1, %0" : "=v"(lp_)); E.pre(epre, cur, wr, wc, lp_ & 15, lp_ >> 4); } }
            const char* a1 = cA + (size_t)(t + 1) * kstep;
            const char* a2 = last ? nA : cA + (size_t)(t + 2) * kstep; const char* b2 = last ? nB : cB + (size_t)(t + 2) * kstep;
            const char* a3 = a2 + kstep; const char* b3 = b2 + kstep;
            PG8_LDB(B0, 0, 0); PG8_LDB(B1, 0, 1); PG8_SCHED; PG8_LDA(At, 0, 0); PG8_STAGE_A(PG8_SA(1, 1), a1, 1, false);
            PG8_WAIT_V8L(); PG8_WAIT_L(0); PG8_BAR; PG8_MMA(0, 0, At, B0); PG8_MMA(0, 1, At, B1); PG8_BAR; PG8_SCHED;
            PG8_LDA(At, 0, 1); PG8_STAGE(PG8_SB(0, 0), b2, voffB); PG8_STAGE(PG8_SB(0, 1), b2 + hstep, voffB); PG8_STAGE_A(PG8_SA(0, 0), a2, 0, last);
            PG8_WAIT_V8L(); PG8_WAIT_L(0); PG8_BAR; PG8_MMA(1, 0, At, B0); PG8_MMA(1, 1, At, B1); PG8_BAR; PG8_SCHED;
            PG8_LDB(B0, 1, 0); PG8_LDB(B1, 1, 1); PG8_SCHED; PG8_LDA(At, 1, 0); PG8_STAGE_A(PG8_SA(0, 1), a2, 1, last);
            PG8_WAIT_V(8); PG8_WAIT_L(0); PG8_BAR; PG8_MMA(0, 0, At, B0); PG8_MMA(0, 1, At, B1); PG8_BAR; PG8_SCHED;
            PG8_LDA(At, 1, 1); PG8_STAGE(PG8_SB(1, 0), b3, voffB); PG8_STAGE(PG8_SB(1, 1), b3 + hstep, voffB); PG8_STAGE_A(PG8_SA(1, 0), a3, 0, last);
            PG8_WAIT_V(8); PG8_WAIT_L(0); PG8_BAR; PG8_MMA(1, 0, At, B0); PG8_MMA(1, 1, At, B1); PG8_BAR; PG8_SCHED;
        }
        if constexpr (F8) asm volatile("s_nop 15\n\ts_nop 15" ::: "memory");
        if constexpr (ALIGN_EPI) { if (wr == 0) PG8_BAR; }
        { int ln_; asm volatile("v_mbcnt_lo_u32_b32 %0, -1, 0\n\tv_mbcnt_hi_u32_b32 %0, -1, %0" : "=v"(ln_));
          if constexpr (Epi::HAS_PRE) E(acc, cur, wr, wc, ln_ & 15, ln_ >> 4, epre); else E(acc, cur, wr, wc, ln_ & 15, ln_ >> 4); }
        if (!has_next) break;
#pragma unroll
        for (int a = 0; a < 2; ++a)
#pragma unroll
            for (int b = 0; b < 2; ++b)
#pragma unroll
                for (int m = 0; m < 4; ++m)
#pragma unroll
                    for (int n = 0; n < 2; ++n) acc[a][b][m][n] = (f32x4){0.f, 0.f, 0.f, 0.f};
        cur = nxt; cA = nA; cB = nB; ++ui;
        if constexpr (GA) {
#pragma unroll
            for (int h = 0; h < 2; ++h)
#pragma unroll
                for (int i = 0; i < 2; ++i) gC[h][i] = gN[h][i]; }
        if constexpr (ALIGN_EPI) { if (wr == 1) PG8_BAR; }
    }
    PG8_WAIT_V(0);
    if constexpr (!ALIGN_EPI) { if (wr == 0) PG8_BAR; }
    PG8_BAR;
#undef PG8_SA
#undef PG8_SB
#undef PG8_STAGE
#undef PG8_STAGE_A
#undef PG8_LDA
#undef PG8_LD8
#undef PG8_LDB
#undef PG8_MMA
#undef PG8_WAIT_V
#undef PG8_WAIT_V8L
#undef PG8_WAIT_L
#undef PG8_BAR
#undef PG8_SCHED
}

typedef f32x4 Acc[2][2][4][2];
__device__ __forceinline__ u32x4 pack8(const f32x4 a, const f32x4 b) { u32x4 w; w.x = cvtpk(a[0], a[1]); w.y = cvtpk(a[2], a[3]); w.z = cvtpk(b[0], b[1]); w.w = cvtpk(b[2], b[3]); return w; }
__device__ __forceinline__ void unpack8(const u32x4 w, f32x4& a, f32x4& b) { a = (f32x4){bflo(w.x), bfhi(w.x), bflo(w.y), bfhi(w.y)}; b = (f32x4){bflo(w.z), bfhi(w.z), bflo(w.w), bfhi(w.w)}; }

struct EpiG1 {
    static constexpr bool PERM = true; static constexpr bool HAS_PRE = false; static constexpr int NPRE = 0; struct Pre {};
    bf16 *QI, *KI; float* WI;
    __device__ __forceinline__ void operator()(const Acc& acc, const Unit& u, int wr, int wc, int fr, int fq) const {
        const int pn = u.pn, row0 = u.pm * BM + wr * 64 + fr, cw = wc * 32 + 8 * fq;
        if (pn == 8) {
#pragma unroll
            for (int ai = 0; ai < 2; ++ai)
#pragma unroll
                for (int m = 0; m < 4; ++m) { const int row = row0 + ai * HALF + m * 16;
                    *(u32x4*)(KI + (size_t)row * 128 + cw) = pack8(acc[ai][0][m][0] * W8_INV, acc[ai][0][m][1] * W8_INV);
                    if (wc == 0 && fq < 2) { float* wp = WI + (size_t)row * 16 + 8 * fq; *(f32x4*)wp = acc[ai][1][m][0] * (IDX_W_SCALE * W8_INV); *(f32x4*)(wp + 4) = acc[ai][1][m][1] * (IDX_W_SCALE * W8_INV); } }
        } else {
#pragma unroll
            for (int ai = 0; ai < 2; ++ai)
#pragma unroll
                for (int m = 0; m < 4; ++m) { bf16* rowp = QI + (size_t)(row0 + ai * HALF + m * 16) * D + pn * 256 + cw;
#pragma unroll
                    for (int bj = 0; bj < 2; ++bj) *(u32x4*)(rowp + bj * HALF) = pack8(acc[ai][bj][m][0] * W8_INV, acc[ai][bj][m][1] * W8_INV); }
        }
    }
};
struct EpiG1b {
    static constexpr bool PERM = true; static constexpr bool HAS_PRE = false; static constexpr int NPRE = 0; struct Pre {};
    unsigned char* ws;
    __device__ __forceinline__ void operator()(const Acc& acc, const Unit& u, int wr, int wc, int fr, int fq) const {
        const int pn = u.pn, row0 = u.pm * BM + wr * 64 + fr, cw = wc * 32 + 8 * fq;
        bf16* const Q = (bf16*)(ws + WS_Q); bf16* const CKV = (bf16*)(ws + WS_CKV); float* const SSQ = (float*)(ws + WS_SSQ); float* const VST = (float*)(ws + WS_VST);
        if (pn == 8) {
#pragma unroll
            for (int ai = 0; ai < 2; ++ai)
#pragma unroll
                for (int m = 0; m < 4; ++m) { const int row = row0 + ai * HALF + m * 16; bf16* rowp = CKV + (size_t)row * 256 + cw; float sq = 0.f;
#pragma unroll
                    for (int bj = 0; bj < 2; ++bj) { const f32x4 v0 = acc[ai][bj][m][0] * W8_INV, v1 = acc[ai][bj][m][1] * W8_INV;
                        sq += (v0[0] * v0[0] + v0[1] * v0[1]) + (v0[2] * v0[2] + v0[3] * v0[3]) + (v1[0] * v1[0] + v1[1] * v1[1]) + (v1[2] * v1[2] + v1[3] * v1[3]);
                        *(u32x4*)(rowp + bj * HALF) = pack8(v0, v1); }
                    sq += __shfl_xor(sq, 16); sq += __shfl_xor(sq, 32);
                    if (fq == 0) SSQ[(size_t)row * 4 + wc] = sq; }
            return; }
        if (pn < 8) {
#pragma unroll
            for (int ai = 0; ai < 2; ++ai)
#pragma unroll
                for (int m = 0; m < 4; ++m) { bf16* rowp = Q + (size_t)(row0 + ai * HALF + m * 16) * D + pn * 256 + cw;
#pragma unroll
                    for (int bj = 0; bj < 2; ++bj) *(u32x4*)(rowp + bj * HALF) = pack8(acc[ai][bj][m][0] * W8_INV, acc[ai][bj][m][1] * W8_INV); }
            return; }
        const int pz = pn - 9;
        bf16* O = (bf16*)(ws + (pz < 8 ? WS_U : (pz < 16 ? WS_V : (pz < 24 ? WS_GA : WS_GB)))); const int colt = pz & 7; const bool gl = pz < 16, st = (pz >> 3) == 1;
#pragma unroll
        for (int ai = 0; ai < 2; ++ai)
#pragma unroll
            for (int m = 0; m < 4; ++m) { const int row = row0 + ai * HALF + m * 16; bf16* rowp = O + (size_t)row * D + colt * 256 + cw; float s1 = 0.f, s2 = 0.f;
#pragma unroll
                for (int bj = 0; bj < 2; ++bj) { f32x4 v0 = acc[ai][bj][m][0] * W8_INV, v1 = acc[ai][bj][m][1] * W8_INV;
                    if (gl) { const f32x2 a = gelu_pk((f32x2){v0[0], v0[1]}), b = gelu_pk((f32x2){v0[2], v0[3]}), c = gelu_pk((f32x2){v1[0], v1[1]}), d = gelu_pk((f32x2){v1[2], v1[3]});
                        v0 = (f32x4){a.x, a.y, b.x, b.y}; v1 = (f32x4){c.x, c.y, d.x, d.y};
                        s1 += (v0[0] + v0[1]) + (v0[2] + v0[3]) + (v1[0] + v1[1]) + (v1[2] + v1[3]);
                        s2 += (v0[0] * v0[0] + v0[1] * v0[1]) + (v0[2] * v0[2] + v0[3] * v0[3]) + (v1[0] * v1[0] + v1[1] * v1[1]) + (v1[2] * v1[2] + v1[3] * v1[3]); }
                    else {
#pragma unroll
                        for (int e = 0; e < 4; ++e) { v0[e] = sigmoidf_(v0[e]); v1[e] = sigmoidf_(v1[e]); } }
                    *(u32x4*)(rowp + bj * HALF) = pack8(v0, v1); }
                if (st) { s1 += __shfl_xor(s1, 16); s1 += __shfl_xor(s1, 32); s2 += __shfl_xor(s2, 16); s2 += __shfl_xor(s2, 32);
                    if (fq == 0) *(f32x2*)(VST + ((size_t)row * 32 + colt * 4 + wc) * 2) = (f32x2){s1, s2}; } }
    }
};
struct EpiKV {
    static constexpr bool PERM = true; static constexpr bool HAS_PRE = false; static constexpr int NPRE = 0; struct Pre {};
    bf16 *KH, *VH; const float* SSQ;
    __device__ __forceinline__ void operator()(const Acc& acc, const Unit& u, int wr, int wc, int fr, int fq) const {
        const int row0 = u.pm * BM + wr * 64 + fr, cw = wc * 32 + 8 * fq;
        bf16* O = u.pn < 8 ? KH : VH; const int colt = (u.pn & 7) * 256;
        f32x4 sq[2][4];
#pragma unroll
        for (int ai = 0; ai < 2; ++ai)
#pragma unroll
            for (int m = 0; m < 4; ++m) sq[ai][m] = *(const f32x4*)(SSQ + (size_t)(row0 + ai * HALF + m * 16) * 4);
#pragma unroll
        for (int ai = 0; ai < 2; ++ai)
#pragma unroll
            for (int m = 0; m < 4; ++m) { const int row = row0 + ai * HALF + m * 16; const f32x4 q = sq[ai][m];
                const float rstd = 1.0f / sqrtf(((q[0] + q[1]) + (q[2] + q[3])) * (1.0f / 256.0f) + EPS);
                bf16* rowp = O + (size_t)row * D + colt + cw;
#pragma unroll
                for (int bj = 0; bj < 2; ++bj) *(u32x4*)(rowp + bj * HALF) = pack8(acc[ai][bj][m][0] * rstd, acc[ai][bj][m][1] * rstd); }
    }
};
template <bool ADD> struct EpiGate {
    static constexpr bool PERM = true; static constexpr bool HAS_PRE = false; static constexpr int NPRE = 0; struct Pre {};
    const bf16* G; const bf16* Y; void* O;
    __device__ __forceinline__ void operator()(const Acc& acc, const Unit& u, int wr, int wc, int fr, int fq) const {
        const int row0 = u.pm * BM + wr * 64 + fr, col0 = u.pn * BM + wc * 32 + 8 * fq;
#pragma unroll
        for (int ai = 0; ai < 2; ++ai) {
            u32x4 gv[4][2], yv[4][2];
#pragma unroll
            for (int m = 0; m < 4; ++m)
#pragma unroll
                for (int bj = 0; bj < 2; ++bj) { const size_t off = (size_t)(row0 + ai * HALF + m * 16) * D + col0 + bj * HALF; gv[m][bj] = *(const u32x4*)(G + off); if (ADD) yv[m][bj] = *(const u32x4*)(Y + off); }
#pragma unroll
            for (int m = 0; m < 4; ++m)
#pragma unroll
                for (int bj = 0; bj < 2; ++bj) { const size_t off = (size_t)(row0 + ai * HALF + m * 16) * D + col0 + bj * HALF; f32x4 g0, g1; unpack8(gv[m][bj], g0, g1);
                    f32x4 v0 = acc[ai][bj][m][0] * W8_INV * g0, v1 = acc[ai][bj][m][1] * W8_INV * g1;
                    if (ADD) { f32x4 y0, y1; unpack8(yv[m][bj], y0, y1); v0 += y0; v1 += y1;
                        u32x2 w; w.x = cvt4_fp8(v0[0], v0[1], v0[2], v0[3]); w.y = cvt4_fp8(v1[0], v1[1], v1[2], v1[3]); *(u32x2*)((unsigned char*)O + off) = w; }
                    else *(u32x4*)((bf16*)O + off) = pack8(v0, v1); } }
    }
};
struct EpiX1 {
    static constexpr bool PERM = false; static constexpr bool HAS_PRE = false; static constexpr int NPRE = 0; struct Pre {};
    const float* X; const float* MODF; float* X1;
    __device__ __forceinline__ void operator()(const Acc& acc, const Unit& u, int wr, int wc, int fr, int fq) const {
        const int row0 = u.pm * BM + wr * 64 + fr, col0 = u.pn * BM + wc * 32 + 4 * fq;
        const float* g1 = MODF + (size_t)(u.pm >> 3) * (6 * D) + 2 * D;
        f32x4 gv[2][2];
#pragma unroll
        for (int bj = 0; bj < 2; ++bj)
#pragma unroll
            for (int n = 0; n < 2; ++n) gv[bj][n] = *(const f32x4*)(g1 + col0 + bj * HALF + n * 16);
#pragma unroll
        for (int ai = 0; ai < 2; ++ai) {
            f32x4 xv[4][2][2];
#pragma unroll
            for (int m = 0; m < 4; ++m)
#pragma unroll
                for (int bj = 0; bj < 2; ++bj)
#pragma unroll
                    for (int n = 0; n < 2; ++n) xv[m][bj][n] = *(const f32x4*)(X + (size_t)(row0 + ai * HALF + m * 16) * D + col0 + bj * HALF + n * 16);
#pragma unroll
            for (int m = 0; m < 4; ++m)
#pragma unroll
                for (int bj = 0; bj < 2; ++bj)
#pragma unroll
                    for (int n = 0; n < 2; ++n) *(f32x4*)(X1 + (size_t)(row0 + ai * HALF + m * 16) * D + col0 + bj * HALF + n * 16) = xv[m][bj][n] + gv[bj][n] * (acc[ai][bj][m][n] * W8_INV); }
    }
};
struct EpiUp {
    static constexpr bool PERM = true, HAS_PRE = true; static constexpr int NPRE = 4;
    struct Pre { f32x4 bg0, bg1, bl0, bl1; };
    const float* BGU; unsigned char* ACT;
    __device__ __forceinline__ void pre(Pre& p, const Unit& u, int wr, int wc, int fr, int fq) const {
        const float* bg = BGU + (size_t)u.e * (2 * DFF) + u.pn * 128 + wc * 32 + 8 * fq;
        gload_x4_untracked(p.bg0, bg); gload_x4_untracked(p.bg1, bg + 4); gload_x4_untracked(p.bl0, bg + DFF); gload_x4_untracked(p.bl1, bg + DFF + 4);
    }
    __device__ __forceinline__ void operator()(const Acc& acc, const Unit& u, int wr, int wc, int fr, int fq, const Pre& p) const {
        const int row0 = u.pm * BM + wr * 64 + fr, j0 = u.pn * 128 + wc * 32 + 8 * fq;
        const f32x4 bg0 = p.bg0, bg1 = p.bg1, bl0 = p.bl0, bl1 = p.bl1;
#pragma unroll
        for (int ai = 0; ai < 2; ++ai)
#pragma unroll
            for (int m = 0; m < 4; ++m) { f32x4 o[2];
#pragma unroll
                for (int n = 0; n < 2; ++n) { const f32x4 hg = acc[ai][0][m][n] * W8_INV + (n ? bg1 : bg0), hl = acc[ai][1][m][n] * W8_INV + (n ? bl1 : bl0);
#pragma unroll
                    for (int e = 0; e < 4; ++e) { const float gg = fminf(hg[e], 7.0f), ll = fminf(fmaxf(hl[e], -7.0f), 7.0f); o[n][e] = gg * sigmoidf_(1.702f * gg) * (ll + 1.0f); } }
                u32x2 w; w.x = cvt4_fp8(o[0][0], o[0][1], o[0][2], o[0][3]); w.y = cvt4_fp8(o[1][0], o[1][1], o[1][2], o[1][3]);
                *(u32x2*)(ACT + (size_t)(row0 + ai * HALF + m * 16) * DFF + j0) = w; }
    }
};
struct EpiDown {
    static constexpr bool PERM = true, HAS_PRE = true; static constexpr int NPRE = 12;
    struct Pre { f32x4 bv[2][2]; float gts[2][4]; };
    const float* BD; const float* RG; bf16* YS;
    __device__ __forceinline__ void pre(Pre& p, const Unit& u, int wr, int wc, int fr, int fq) const {
        const float* bd = BD + (size_t)u.e * D + u.pn * BM + wc * 32 + 8 * fq; const int row0 = u.pm * BM + wr * 64 + fr;
#pragma unroll
        for (int bj = 0; bj < 2; ++bj) { gload_x4_untracked(p.bv[bj][0], bd + bj * HALF); gload_x4_untracked(p.bv[bj][1], bd + bj * HALF + 4); }
#pragma unroll
        for (int ai = 0; ai < 2; ++ai)
#pragma unroll
            for (int m = 0; m < 4; ++m) gload_x1_untracked(p.gts[ai][m], RG + row0 + ai * HALF + m * 16);
    }
    __device__ __forceinline__ void operator()(const Acc& acc, const Unit& u, int wr, int wc, int fr, int fq, const Pre& p) const {
        const int row0 = u.pm * BM + wr * 64 + fr, col0 = u.pn * BM + wc * 32 + 8 * fq;
#pragma unroll
        for (int ai = 0; ai < 2; ++ai)
#pragma unroll
            for (int m = 0; m < 4; ++m) { const int row = row0 + ai * HALF + m * 16; const float gt = p.gts[ai][m]; bf16* rowp = YS + (size_t)row * D + col0;
#pragma unroll
                for (int bj = 0; bj < 2; ++bj) *(u32x4*)(rowp + bj * HALF) = pack8((acc[ai][bj][m][0] * W8_INV + p.bv[bj][0]) * gt, (acc[ai][bj][m][1] * W8_INV + p.bv[bj][1]) * gt); }
    }
};
}

namespace att {
constexpr int DH = 128, PITCH = 2048, NW = 8, QBLK = 32, KVBLK = 64, QB = NW * QBLK;
constexpr int SHM_V = KVBLK * DH * 2, SHM_K = KVBLK * DH * 2;
constexpr int ATT_KV_BYTES = 2 * SHM_V + 2 * SHM_K + NW * 64 * 4;
constexpr int MWAVE = 8192;
constexpr int ATT_LDS_BYTES = ATT_KV_BYTES + NW * MWAVE;
constexpr float SCALE = 0.08838834764831845f, THR = 8.f;
#define KSWZ(row, colB) ((row) * 256 + ((colB) ^ (((row) & 7) << 4)))
#define SBAR() __builtin_amdgcn_sched_barrier(0)
__device__ __forceinline__ int v_st(int k, int c) { const int kk = (k & ~0xC) | ((k & 4) << 1) | ((k & 8) >> 1); return ((kk >> 3) * 4 + (c >> 5)) * 512 + ((kk & 7) * 32 + (c & 31)) * 2; }
__device__ __forceinline__ int v_rd_base(int lane) { return ((lane & 3) << 3) | (((lane >> 2) & 3) << 6) | (((lane >> 4) & 1) << 5) | (((lane >> 5) & 1) << 8); }
constexpr int v_rd_off(int d0, int ks, int half) { return d0 * 512 + ks * 4096 + half * 2048; }
__device__ __forceinline__ int crow(int r, int hi) { return (r & 3) + 8 * (r >> 2) + 4 * hi; }
__device__ __forceinline__ bf16x8 load8(const bf16* p) { return *reinterpret_cast<const bf16x8*>(p); }
__device__ __forceinline__ void mask_bits(f32x16& p0, f32x16& p1, unsigned w0, unsigned w1, int hi) {
    const unsigned a0 = w0 >> (4 * hi), a1 = w1 >> (4 * hi);
    const unsigned NEGB = 0xff800000u;
#pragma unroll
    for (int r = 0; r < 16; ++r) {
        const int c = (r & 3) + 8 * (r >> 2);
        const unsigned m0 = (unsigned)__builtin_amdgcn_sbfe((int)a0, c, 1), m1 = (unsigned)__builtin_amdgcn_sbfe((int)a1, c, 1);
        p0[r] = __uint_as_float((__float_as_uint(p0[r]) & m0) | (NEGB & ~m0));
        p1[r] = __uint_as_float((__float_as_uint(p1[r]) & m1) | (NEGB & ~m1));
    }
}
__device__ __forceinline__ void partialSM(f32x16& p0, f32x16& p1, float& m_reg, float& mn, float& alpha) {
    float pmax = p0[0];
#pragma unroll
    for (int r = 1; r < 16; ++r) pmax = fmaxf(pmax, p0[r]);
#pragma unroll
    for (int r = 0; r < 16; ++r) pmax = fmaxf(pmax, p1[r]);
    { auto rr = __builtin_amdgcn_permlane32_swap(__float_as_uint(pmax), __float_as_uint(pmax), false, false);
      pmax = fmaxf(__uint_as_float(rr[0]), __uint_as_float(rr[1])); }
    constexpr float C2 = 1.4426950408889634f * SCALE;
    if (__builtin_expect(__all((pmax - m_reg) * SCALE <= THR), 1)) { mn = m_reg; alpha = 1.f; }
    else { mn = fmaxf(m_reg, pmax); alpha = __builtin_amdgcn_exp2f((m_reg - mn) * C2); m_reg = mn; }
    const float mnL = -mn * C2;
#pragma unroll
    for (int r = 0; r < 16; ++r) p0[r] = fmaf(p0[r], C2, mnL);
#pragma unroll
    for (int r = 0; r < 16; ++r) p1[r] = fmaf(p1[r], C2, mnL);
#pragma unroll
    for (int r = 0; r < 16; ++r) p0[r] = __builtin_amdgcn_exp2f(p0[r]);
}
__device__ __forceinline__ void finishSM(f32x16& p0, f32x16& p1, float alpha, float& l_reg, bf16x8& pa0, bf16x8& pa1, bf16x8& pa2, bf16x8& pa3) {
#pragma unroll
    for (int r = 0; r < 16; ++r) p1[r] = __builtin_amdgcn_exp2f(p1[r]);
    float ps = 0;
#pragma unroll
    for (int r = 0; r < 16; ++r) ps += p0[r];
#pragma unroll
    for (int r = 0; r < 16; ++r) ps += p1[r];
    { auto rr = __builtin_amdgcn_permlane32_swap(__float_as_uint(ps), __float_as_uint(ps), false, false);
      ps = __uint_as_float(rr[0]) + __uint_as_float(rr[1]); }
    l_reg = l_reg * alpha + ps;
#define PK4(P, B_, OUT) do { unsigned a0 = cvtpk(P[B_+0], P[B_+1]), a1 = cvtpk(P[B_+2], P[B_+3]);                          \
        unsigned b0 = cvtpk(P[B_+4], P[B_+5]), b1 = cvtpk(P[B_+6], P[B_+7]);                                             \
        auto r0 = __builtin_amdgcn_permlane32_swap(a0, b0, false, false); auto r1 = __builtin_amdgcn_permlane32_swap(a1, b1, false, false); \
        u32x4 w = {r0[0], r1[0], r0[1], r1[1]}; OUT = *reinterpret_cast<bf16x8*>(&w); } while (0)
    PK4(p0, 0, pa0); PK4(p0, 8, pa1); PK4(p1, 0, pa2); PK4(p1, 8, pa3);
#undef PK4
}
template <int KB>
__device__ __forceinline__ void qkt(f32x16& p0, f32x16& p1, const char* K_lds, int r32, int hi, const bf16x8* qr) {
    p0 = f32x16{}; p1 = f32x16{};
    const char* kb[4];
#pragma unroll
    for (int dd = 0; dd < 4; ++dd) kb[dd] = K_lds + KB * SHM_K + KSWZ(r32, (dd * 16 + hi * 8) * 2);
#pragma unroll
    for (int d0 = 0; d0 < 8; ++d0) { const char* a = kb[d0 & 3] + (d0 >> 2) * 128;
        bf16x8 b0 = *reinterpret_cast<const bf16x8*>(a);
        bf16x8 b1 = *reinterpret_cast<const bf16x8*>(a + 32 * 256);
        p0 = __builtin_amdgcn_mfma_f32_32x32x16_bf16(b0, qr[d0], p0, 0, 0, 0);
        p1 = __builtin_amdgcn_mfma_f32_32x32x16_bf16(b1, qr[d0], p1, 0, 0, 0); }
}
template <int VB>
__device__ __forceinline__ void pv_tile(f32x16* o, int vb0, bf16x8 pa0, bf16x8 pa1, bf16x8 pa2, bf16x8 pa3) {
#define TRRD(dst, off) asm volatile("ds_read_b64_tr_b16 %0, %1 offset:%2" : "=&v"(dst) : "v"(vb0), "i"(off) : "memory")
#define PV_D0(d0) do { s16x4 l0, l1, l2, l3, h0, h1, h2, h3; constexpr int b_ = VB * SHM_V + v_rd_off(d0, 0, 0); \
        TRRD(l0, b_); TRRD(h0, b_ + 2048); TRRD(l1, b_ + 4096); TRRD(h1, b_ + 6144); TRRD(l2, b_ + 8192); TRRD(h2, b_ + 10240); TRRD(l3, b_ + 12288); TRRD(h3, b_ + 14336); \
        asm volatile("s_waitcnt lgkmcnt(0)" ::: "memory"); SBAR();   \
        o[d0] = __builtin_amdgcn_mfma_f32_32x32x16_bf16(pa0, (bf16x8){l0[0], l0[1], l0[2], l0[3], h0[0], h0[1], h0[2], h0[3]}, o[d0], 0, 0, 0);   \
        o[d0] = __builtin_amdgcn_mfma_f32_32x32x16_bf16(pa1, (bf16x8){l1[0], l1[1], l1[2], l1[3], h1[0], h1[1], h1[2], h1[3]}, o[d0], 0, 0, 0);   \
        o[d0] = __builtin_amdgcn_mfma_f32_32x32x16_bf16(pa2, (bf16x8){l2[0], l2[1], l2[2], l2[3], h2[0], h2[1], h2[2], h2[3]}, o[d0], 0, 0, 0);   \
        o[d0] = __builtin_amdgcn_mfma_f32_32x32x16_bf16(pa3, (bf16x8){l3[0], l3[1], l3[2], l3[3], h3[0], h3[1], h3[2], h3[3]}, o[d0], 0, 0, 0); } while (0)
    PV_D0(0); PV_D0(1); PV_D0(2); PV_D0(3);
#undef PV_D0
#undef TRRD
}

struct BlockRef { const bf16* Q; const bf16* K; const bf16* V; bf16* O; const unsigned* M; int P0; };
struct Seam { bf16x8 qr[8]; bf16x8 st_v0, st_v1, st_k0, st_k1; };
#define ROW(p, k0, r32c) ((const bf16*)((const char*)(p) + (size_t)((k0) + (r32c)) * (PITCH * 2) + rvo))
#define VMW() asm volatile("s_waitcnt vmcnt(0)" ::: "memory")
#define VMWN(n) asm volatile("s_waitcnt vmcnt(%0)" :: "i"(n) : "memory")
#define SLOAD_H(Kp, Vp, k0) do { S.st_v0 = load8(ROW(Vp, k0, 0)); S.st_v1 = load8(ROW(Vp, k0, 32));              \
                         S.st_k0 = load8(ROW(Kp, k0, 0)); S.st_k1 = load8(ROW(Kp, k0, 32)); } while (0)
#define SWRITE_HK(bf) do { *(bf16x8*)(K_lds + (bf) * SHM_K + kws) = S.st_k0; *(bf16x8*)(K_lds + (bf) * SHM_K + kws + 32 * 256) = S.st_k1; } while (0)
#define SWRITE_HV(bf) do { *(bf16x8*)(V_lds + (bf) * SHM_V + vst0) = S.st_v0; *(bf16x8*)(V_lds + (bf) * SHM_V + vst1) = S.st_v1; } while (0)
#define SWRITE_H(bf) do { SWRITE_HV(bf); SWRITE_HK(bf); } while (0)
__device__ __forceinline__ void mask_dma(const BlockRef& b, char* lds, int wid, int r32, int hi) {
    const int nt = (b.P0 + QB - 1) / KVBLK + 1;
    const char* mg = (const char*)b.M + (unsigned)((wid * QBLK + r32) * 256 + 16 * hi);
    LAS char* ml = (LAS char*)lds + ATT_KV_BYTES + wid * MWAVE;
    for (int jj = 0; jj < (nt + 3) / 4; ++jj) __builtin_amdgcn_global_load_lds((const unsigned*)(mg + 32 * jj), (LAS unsigned*)(ml + 1024 * jj), 16, 0, 0);
}
#define MASK_RD(t) (*(const LAS u32x2*)(mlane + (((t) >> 2) * 1024 + (((t) >> 1) & 1) * 512 + ((t) & 1) * 8)))
__device__ __forceinline__ void attn_prime(const BlockRef& cur, char* lds, Seam& S) {
    const int tid = threadIdx.x, wid = __builtin_amdgcn_readfirstlane(tid >> 6), lane = tid & 63, r32 = lane & 31, hi = lane >> 5;
    const int sr = tid >> 4, sc = (tid & 15) * 8, kws = KSWZ(sr, sc * 2); char* K_lds = lds + 2 * SHM_V; const unsigned rvo = (unsigned)((sr * PITCH + sc) * 2);
#pragma unroll
    for (int d0 = 0; d0 < 8; ++d0) S.qr[d0] = load8((const bf16*)((const char*)cur.Q + (unsigned)(((wid * QBLK + r32) * PITCH + hi * 8) * 2 + d0 * 32)));
    SLOAD_H(cur.K, cur.V, 0); mask_dma(cur, lds, wid, r32, hi); VMW(); SWRITE_HK(0);
    __syncthreads();
}
__device__ __forceinline__ void attn_block(const BlockRef& cur, const BlockRef& nxt, char* lds, Seam& S) {
    const int tid = threadIdx.x, wid = __builtin_amdgcn_readfirstlane(tid >> 6), lane = tid & 63, r32 = lane & 31, hi = lane >> 5;
    const int NT = (cur.P0 + QB - 1) / KVBLK + 1;
    char* V_lds = lds; char* K_lds = lds + 2 * SHM_V;
    float* ws = (float*)(lds + 2 * SHM_V + 2 * SHM_K) + wid * 64; float* li_l = ws, * al_l = ws + 32;
    float m_reg = -1e30f, l_reg = 0; f32x16 o[4] = {};
    const int sr = tid >> 4, sc = (tid & 15) * 8, vst0 = v_st(sr, sc), vst1 = v_st(32 + sr, sc), kws = KSWZ(sr, sc * 2); const unsigned rvo = (unsigned)((sr * PITCH + sc) * 2);
    const int vb0 = (int)(uintptr_t)V_lds + v_rd_base(lane);
    const bf16* Kh = cur.K; const bf16* Vh = cur.V;
    LAS char* mlane = (LAS char*)lds + ATT_KV_BYTES + wid * MWAVE + r32 * 16;
#define RESC(a) do { if (__any((a) < 1.f)) { if (hi == 0) al_l[r32] = (a); asm volatile("s_waitcnt lgkmcnt(0)" ::: "memory");              \
                     for (int d_ = 0; d_ < 4; ++d_) for (int r = 0; r < 16; ++r) o[d_][r] *= al_l[crow(r, hi)]; } } while (0)
#define KBASE(t) ((t) * KVBLK)
#ifdef ATT_NOMASK
#define MASKT(P0_, P1_, mw_) do { } while (0)
#else
#define MASKT(P0_, P1_, mw_) do { unsigned w0_ = (mw_).x, w1_ = (mw_).y; asm volatile("" : "+v"(w0_), "+v"(w1_)); mask_bits(P0_, P1_, w0_, w1_, hi); } while (0)
#endif
    constexpr int NQL = 8;
#define SEAM_K0() do { VMWN(NQL); SWRITE_HK(0); SBAR(); } while (0)
    f32x16 pA0, pA1, pB0, pB1; float mnA, mnB, alA, alB; bf16x8 pa0, pa1, pa2, pa3;
    { SWRITE_HV(0); SBAR();
      SLOAD_H(Kh, Vh, KBASE(1));
      SBAR(); qkt<0>(pA0, pA1, K_lds, r32, hi, S.qr);
      VMWN(4);
      { const u32x2 mw0 = MASK_RD(0); MASKT(pA0, pA1, mw0); } partialSM(pA0, pA1, m_reg, mnA, alA); }
    if (NT > 1) { VMW(); SWRITE_H(1); }
    __syncthreads();
#define HALF_STEP(PX0, PX1, mnX, alX, PY0, PY1, alY, t, KB, VB, SB) do {                                                      \
        SBAR(); qkt<KB>(PX0, PX1, K_lds, r32, hi, S.qr);                                                                      \
        finishSM(PY0, PY1, alY, l_reg, pa0, pa1, pa2, pa3); SBAR();                                                           \
        if ((t) + 1 < NT) { SLOAD_H(Kh, Vh, KBASE((t) + 1)); SBAR(); }                                                        \
        pv_tile<VB>(o, vb0, pa0, pa1, pa2, pa3); { const u32x2 mw_ = MASK_RD(t); MASKT(PX0, PX1, mw_); } partialSM(PX0, PX1, m_reg, mnX, alX);                  \
        __syncthreads();                                                                                                      \
        if ((t) + 1 < NT) { VMW(); SWRITE_H(SB); }                                                                            \
        RESC(alX); __syncthreads(); } while (0)
    for (int t = 1; t + 1 < NT; t += 2) {
        HALF_STEP(pB0, pB1, mnB, alB, pA0, pA1, alA, t, 1, 0, 0);
        HALF_STEP(pA0, pA1, mnA, alA, pB0, pB1, alB, t + 1, 0, 1, 1);
    }
    const bool even = (NT & 1) == 0;
    if (even) { SBAR(); qkt<1>(pB0, pB1, K_lds, r32, hi, S.qr); SBAR(); }
    SLOAD_H(nxt.K, nxt.V, 0); SBAR();
#pragma unroll
    for (int d0 = 0; d0 < 8; ++d0) S.qr[d0] = load8((const bf16*)((const char*)nxt.Q + (unsigned)(((wid * QBLK + r32) * PITCH + hi * 8) * 2 + d0 * 32)));
    SBAR();
    finishSM(pA0, pA1, alA, l_reg, pa0, pa1, pa2, pa3); SBAR();
    pv_tile<0>(o, vb0, pa0, pa1, pa2, pa3);
    if (even) { { const u32x2 mwl = MASK_RD(NT - 1); MASKT(pB0, pB1, mwl); } partialSM(pB0, pB1, m_reg, mnB, alB); __syncthreads(); RESC(alB);
        finishSM(pB0, pB1, alB, l_reg, pa0, pa1, pa2, pa3); SBAR(); pv_tile<1>(o, vb0, pa0, pa1, pa2, pa3); }
    SBAR(); asm volatile("s_waitcnt lgkmcnt(0)" ::: "memory"); mask_dma(nxt, lds, wid, r32, hi); SBAR(); SEAM_K0();
    if (hi == 0) li_l[r32] = l_reg; asm volatile("s_waitcnt lgkmcnt(0)" ::: "memory");
    int tz; asm volatile("v_mbcnt_lo_u32_b32 %0, -1, 0\n\tv_mbcnt_hi_u32_b32 %0, -1, %0" : "=v"(tz)); const int hib = (tz >> 5) & 1, r32b = tz & 31, widb = wid;
    float rli[16];
#pragma unroll
    for (int r = 0; r < 16; ++r) rli[r] = __builtin_amdgcn_rcpf(li_l[crow(r, hib)]);
    unsigned char* Ow = (unsigned char*)cur.O + (unsigned)((widb * QBLK + 4 * hib) * PITCH + r32b);
#pragma unroll
    for (int r = 0; r < 16; ++r) {
#pragma unroll
        for (int d0 = 0; d0 < 4; ++d0) { const float v = o[d0][r] * rli[r];
            const float v1 = __shfl_xor(v, 1); const float lo = (r32b & 1) ? v1 : v, hi2 = (r32b & 1) ? v : v1;
            const float lo2 = __shfl_xor(lo, 2), hi3 = __shfl_xor(hi2, 2);
            if ((r32b & 3) == 0) *(GAS unsigned*)(Ow + d0 * 32) = cvt4_fp8(lo, hi2, lo2, hi3); }
        Ow += ((r & 3) == 3 ? 5 : 1) * PITCH; asm volatile("" : "+v"(Ow)); }
    __syncthreads();
#undef RESC
#undef KBASE
#undef MASKT
#undef SEAM_K0
#undef HALF_STEP
}
#undef ROW
#undef SLOAD_H
#undef SWRITE_HK
#undef SWRITE_HV
#undef SWRITE_H
}

#define XB_TMO      128
#define XB_XCNT(j)  (256  + 64 * (j))
#define XB_XSUB(j)  (1280 + 64 * (j))
#define XB_XGEN(j)  (2304 + 64 * (j))
#define XB_TOP      3328
#define XB_TOPGEN   3392
#define XCD_BAR_WORDS 3456
#define XB_SPIN_CAP (1u << 18)
__device__ __forceinline__ unsigned xb_ld(unsigned* p)              { return __hip_atomic_load(p, __ATOMIC_RELAXED, __HIP_MEMORY_SCOPE_AGENT); }
__device__ __forceinline__ unsigned xb_add(unsigned* p, unsigned v) { return __hip_atomic_fetch_add(p, v, __ATOMIC_RELAXED, __HIP_MEMORY_SCOPE_AGENT); }
__device__ __forceinline__ unsigned xb_xcc_id() { return (unsigned)__builtin_amdgcn_s_getreg((3 << 11) | 20) & 0xFu; }
#define XB_SPIN(cond, bar) do { unsigned _sp = 0; while (cond) { __builtin_amdgcn_s_sleep(1); \
    if ((++_sp & 255u) == 0u) { if (xb_ld(&(bar)[XB_TMO])) break; if (_sp > XB_SPIN_CAP) { atomicAdd(&(bar)[XB_TMO], 1u); break; } } } } while (0)
struct XcdBarrier { unsigned* bar; unsigned x; volatile LAS unsigned* st; };
__device__ __forceinline__ XcdBarrier xcd_barrier_post(unsigned* bar, volatile LAS unsigned* st) {
    XcdBarrier b; b.bar = bar; b.x = xb_xcc_id(); b.st = st;
    if (threadIdx.x == 0) (void)xb_add(&bar[XB_XCNT(b.x)], 1u);
    return b;
}
__device__ __forceinline__ void xcd_barrier_complete(unsigned* bar, unsigned x, unsigned& nloc, unsigned& nx) {
    const unsigned G = gridDim.x * gridDim.y * gridDim.z;
    unsigned sum, cnt, mine, sp = 0u;
    for (;;) {
        sum = 0u; cnt = 0u; mine = 0u;
#pragma unroll
        for (unsigned j = 0; j < 16; ++j) { const unsigned c = xb_ld(&bar[XB_XCNT(j)]); sum += c; cnt += (c > 0u) ? 1u : 0u; mine = (j == x) ? c : mine; }
        if (sum == G) break;
        __builtin_amdgcn_s_sleep(1);
        if ((++sp & 255u) == 0u) { if (xb_ld(&bar[XB_TMO])) break; if (sp > XB_SPIN_CAP) { atomicAdd(&bar[XB_TMO], 1u); break; } }
    }
    nloc = mine > 0u ? mine : 1u; nx = cnt > 0u ? cnt : 1u;
}
__device__ __forceinline__ void xcd_barrier(const XcdBarrier& b) {
    asm volatile("s_waitcnt vmcnt(0)" ::: "memory");
    __syncthreads();
    if (threadIdx.x == 0) {
        unsigned* bar = b.bar;
        __builtin_amdgcn_s_waitcnt(0);
        unsigned nloc = b.st[0], nx = b.st[1];
        if (nloc == 0u) { xcd_barrier_complete(bar, b.x, nloc, nx); b.st[0] = nloc; b.st[1] = nx; }
        const unsigned old = xb_add(&bar[XB_XSUB(b.x)], 1u);
        const unsigned gen = old / nloc;
        if (old + 1u == (gen + 1u) * nloc) {
            __builtin_amdgcn_fence(__ATOMIC_RELEASE, "agent");
            asm volatile("s_waitcnt vmcnt(0)" ::: "memory");
            const unsigned og = xb_add(&bar[XB_TOP], 1u);
            const unsigned tg = og / nx;
            if (og + 1u == (tg + 1u) * nx) xb_add(&bar[XB_TOPGEN], 1u);
            else XB_SPIN(xb_ld(&bar[XB_TOPGEN]) == tg, bar);
            __builtin_amdgcn_fence(__ATOMIC_ACQUIRE, "agent");
            xb_add(&bar[XB_XGEN(b.x)], 1u);
            asm volatile("s_waitcnt vmcnt(0)" ::: "memory");
        } else {
            XB_SPIN(xb_ld(&bar[XB_XGEN(b.x)]) == gen, bar);
            __builtin_amdgcn_fence(__ATOMIC_ACQUIRE, "agent");
            asm volatile("s_waitcnt vmcnt(0)" ::: "memory");
        }
    }
    __syncthreads();
}

struct Args { const float* in[23]; float* out; unsigned char* ws; int ph_lo, ph_hi; };
enum { I_X = 0, I_C, I_WMOD, I_BMOD, I_N1G, I_WIN, I_KVG, I_WUK, I_WUV, I_WPA, I_SGG, I_WSP, I_BSP, I_WPB, I_WOUT, I_N2G, I_WR, I_BR, I_WGU, I_BGU, I_WD, I_BD, I_FG };

struct Frame { LAS unsigned char* lds; int tid, lane, wave, vcu, G; };

template <class SrcF>
__device__ __forceinline__ void transpose_item(const float* W, int ldw, bf16* WT, int ldt, int k0, int n0, LAS float* scr, int lane, SrcF srcf, const float* kscale) {
    const int sc = srcf(n0 + (lane & 31));
    float tv[32];
#pragma unroll
    for (int i = 0; i < 32; ++i) { const int kk = 2 * i + (lane >> 5); tv[i] = W[(size_t)(k0 + kk) * ldw + (sc >= 0 ? sc : 0)]; }
#pragma unroll
    for (int i = 0; i < 32; ++i) { const int kk = 2 * i + (lane >> 5); float v = sc >= 0 ? tv[i] : 0.f; if (kscale) v *= kscale[k0 + kk]; scr[kk * 33 + (lane & 31)] = v; }
    LDS_WAIT(); asm volatile("" ::: "memory");
    const int c = lane & 7;
#pragma unroll
    for (int j = 0; j < 4; ++j) { const int n = (lane >> 3) + 8 * j; const LAS float* s = scr + (8 * c) * 33 + n;
        u32x4 o; o.x = cvtpk(s[0 * 33], s[1 * 33]); o.y = cvtpk(s[2 * 33], s[3 * 33]); o.z = cvtpk(s[4 * 33], s[5 * 33]); o.w = cvtpk(s[6 * 33], s[7 * 33]);
        *(u32x4*)(WT + (size_t)(n0 + n) * ldt + k0 + 8 * c) = o; }
    LDS_WAIT(); asm volatile("" ::: "memory");
}

template <bool F8, class DRow>
__device__ __forceinline__ void conv_item(const float* W, int ldw, int N, void* WT, int ldt, int k0, int c0, int lane, DRow drow, float scale) {
    constexpr int KS = F8 ? 16 : 8, NSTEP = 8;
    const int c = c0 + 4 * lane; const bool ok = c + 3 < N;
    const float* src = W + (size_t)k0 * ldw + (ok ? c : 0);
    char* dp[4];
#pragma unroll
    for (int j = 0; j < 4; ++j) dp[j] = (char*)WT + ((size_t)drow(ok ? c + j : 0) * ldt + k0) * (F8 ? 1 : 2);
    f32x4 cur[KS], nxt[KS];
#pragma unroll
    for (int i = 0; i < KS; ++i) cur[i] = *(const f32x4*)(src + (size_t)i * ldw);
#pragma unroll
    for (int st = 0; st < NSTEP; ++st) {
        if (st + 1 < NSTEP) {
#pragma unroll
            for (int i = 0; i < KS; ++i) nxt[i] = *(const f32x4*)(src + (size_t)((st + 1) * KS + i) * ldw); }
#pragma unroll
        for (int j = 0; j < 4; ++j) { u32x4 o;
            if constexpr (F8) { o.x = cvt4_fp8(cur[0][j] * scale, cur[1][j] * scale, cur[2][j] * scale, cur[3][j] * scale); o.y = cvt4_fp8(cur[4][j] * scale, cur[5][j] * scale, cur[6][j] * scale, cur[7][j] * scale);
                                o.z = cvt4_fp8(cur[8][j] * scale, cur[9][j] * scale, cur[10][j] * scale, cur[11][j] * scale); o.w = cvt4_fp8(cur[12][j] * scale, cur[13][j] * scale, cur[14][j] * scale, cur[15][j] * scale); }
            else { o.x = cvtpk(cur[0][j], cur[1][j]); o.y = cvtpk(cur[2][j], cur[3][j]); o.z = cvtpk(cur[4][j], cur[5][j]); o.w = cvtpk(cur[6][j], cur[7][j]); }
            if (ok) *(u32x4*)(dp[j] + st * 16) = o; }
        if (st + 1 < NSTEP) {
#pragma unroll
            for (int i = 0; i < KS; ++i) cur[i] = nxt[i]; }
    }
}

template <class SrcF>
__device__ __forceinline__ void transpose_item8(const float* W, int ldw, unsigned char* WT, int ldt, int k0, int n0, LAS float* scr, int lane, SrcF srcf, float scale) {
    const int sc = srcf(n0 + (lane & 31));
    float tv[64];
#pragma unroll
    for (int i = 0; i < 64; ++i) { const int kk = 2 * i + (lane >> 5); tv[i] = W[(size_t)(k0 + kk) * ldw + sc]; }
#pragma unroll
    for (int i = 0; i < 64; ++i) { const int kk = 2 * i + (lane >> 5); scr[kk * 33 + (lane & 31)] = tv[i] * scale; }
    LDS_WAIT(); asm volatile("" ::: "memory");
    const int c = lane & 7;
#pragma unroll
    for (int j = 0; j < 4; ++j) { const int n = (lane >> 3) + 8 * j; const LAS float* s = scr + (16 * c) * 33 + n;
        u32x4 o; o.x = cvt4_fp8(s[0 * 33], s[1 * 33], s[2 * 33], s[3 * 33]); o.y = cvt4_fp8(s[4 * 33], s[5 * 33], s[6 * 33], s[7 * 33]);
        o.z = cvt4_fp8(s[8 * 33], s[9 * 33], s[10 * 33], s[11 * 33]); o.w = cvt4_fp8(s[12 * 33], s[13 * 33], s[14 * 33], s[15 * 33]);
        *(u32x4*)(WT + (size_t)(n0 + n) * ldt + k0 + 16 * c) = o; }
    LDS_WAIT(); asm volatile("" ::: "memory");
}

__device__ __forceinline__ void moe_conv(const Frame& F, const Args& a) {
    unsigned char* ws = a.ws;
    { constexpr int TPE_GU = 16 * 32, TPE_DN = 16 * 16, NT_GU = NE * TPE_GU, NTILE = NT_GU + NE * TPE_DN;
      LAS unsigned char* fb = F.lds;
      LAS unsigned* stg = (LAS unsigned*)(F.lds + 131072);
      auto issue = [&](int t, int buf) {
          const float* W; int ldw, k0, c0;
          if (t < NT_GU) { const int e = t / TPE_GU, q = t % TPE_GU; W = a.in[I_WGU] + (size_t)e * D * (2 * DFF); ldw = 2 * DFF; k0 = 128 * (q & 15); c0 = 128 * (q >> 4); }
          else { const int r = t - NT_GU, e = r / TPE_DN, q = r % TPE_DN; W = a.in[I_WD] + (size_t)e * DFF * D; ldw = D; k0 = 128 * (q & 15); c0 = 128 * (q >> 4); }
          const float* p = W + (size_t)(k0 + 16 * F.wave + (F.lane >> 5)) * ldw + c0 + 4 * (F.lane & 31);
#pragma unroll
          for (int i = 0; i < 8; ++i)
              __builtin_amdgcn_global_load_lds((const unsigned*)(p + (size_t)(2 * i) * ldw), (LAS unsigned*)(fb + buf * 65536 + (16 * F.wave + 2 * i) * 512), 16, 0, 2); };
      auto convert = [&](int buf) {
          const LAS unsigned char* src = fb + buf * 65536 + (16 * F.wave) * 512 + F.lane * 8;
          f32x2 v[16];
#pragma unroll
          for (int r = 0; r < 16; ++r) v[r] = *(const LAS f32x2*)(src + r * 512);
#pragma unroll
          for (int kq = 0; kq < 4; ++kq) { u32x2 w;
              w.x = cvt4_fp8(v[4 * kq][0] * W8_SCALE, v[4 * kq + 1][0] * W8_SCALE, v[4 * kq + 2][0] * W8_SCALE, v[4 * kq + 3][0] * W8_SCALE);
              w.y = cvt4_fp8(v[4 * kq][1] * W8_SCALE, v[4 * kq + 1][1] * W8_SCALE, v[4 * kq + 2][1] * W8_SCALE, v[4 * kq + 3][1] * W8_SCALE);
              *(LAS u32x2*)(stg + (4 * F.wave + kq) * 128 + 2 * F.lane) = w; } };
      auto store_tile = [&](int t) {
          unsigned char* WT; int ldt, k0, c0; const bool gu = t < NT_GU;
          if (gu) { const int e = t / TPE_GU, q = t % TPE_GU; WT = (unsigned char*)(ws + WS_WGU) + (size_t)e * (2 * DFF) * D; ldt = D; k0 = 128 * (q & 15); c0 = 128 * (q >> 4); }
          else { const int r = t - NT_GU, e = r / TPE_DN, q = r % TPE_DN; WT = (unsigned char*)(ws + WS_WD) + (size_t)e * D * DFF; ldt = DFF; k0 = 128 * (q & 15); c0 = 128 * (q >> 4); }
          const int c = F.tid & 7;
#pragma unroll
          for (int j = 0; j < 2; ++j) { const int nl = (F.tid >> 3) + 64 * j, n = c0 + nl; const LAS unsigned* sp = stg + (4 * c) * 128 + nl;
              u32x4 o; o.x = sp[0]; o.y = sp[128]; o.z = sp[256]; o.w = sp[384];
              const int drow = gu ? (((n & 2047) >> 7) * 256 + (n >> 11) * 128 + (n & 127)) : n;
              __builtin_nontemporal_store(o, (u32x4*)(WT + (size_t)drow * ldt + k0 + 16 * c)); } };
#define MC_STEP(s_, buf_) do { if ((s_) > 0) store_tile(tix((s_) - 1)); LDS_BARRIER(); \
          asm volatile("s_waitcnt vmcnt(8)" ::: "memory"); convert(buf_); asm volatile("s_waitcnt lgkmcnt(0)" ::: "memory"); issue(tix((s_) + 2), buf_); LDS_BARRIER(); } while (0)
      const int t0 = F.vcu, nw = t0 < NTILE ? (NTILE - 1 - t0) / F.G + 1 : 0;
      if (nw > 0) {
          const int tl = t0 + (nw - 1) * F.G;
          auto tix = [&](int s) { const int x = t0 + s * F.G; return x < tl ? x : tl; };
          issue(tix(0), 0); issue(tix(1), 1);
#pragma unroll 1
          for (int s = 0; s < nw; s += 2) { MC_STEP(s, 0); MC_STEP(s + 1, 1); }
          store_tile(tl);
          VM_WAIT(); }
#undef MC_STEP
      __syncthreads(); }
}

__device__ __forceinline__ void win_conv(const Frame& F, const Args& a) {
    unsigned char* ws = a.ws;
    constexpr int NT_B = 16 * (NIN_B / 128), NT_A = 16 * (NIN_A / 128), NT_SQ = 16 * 16, NTILE = NT_B + NT_A + 3 * NT_SQ;
    LAS unsigned char* fb = F.lds;
    LAS unsigned* stg = (LAS unsigned*)(F.lds + 131072);
    auto decode = [&](int t, const float*& src, int& ldw, int& valid, unsigned char*& dst) {
        if (t < NT_B) { const int kb = t & 15, n0 = 128 * (t >> 4); src = a.in[I_WIN] + (size_t)(128 * kb) * NIN_SRC + (n0 < 2304 ? n0 : n0 + 2192); ldw = NIN_SRC; valid = 128;
            dst = (unsigned char*)(ws + WS_WIN8) + (size_t)n0 * D + 128 * kb; return; }
        t -= NT_B;
        if (t < NT_A) { const int kb = t & 15, n0 = 128 * (t >> 4); src = a.in[I_WIN] + (size_t)(128 * kb) * NIN_SRC + n0 + 2304; ldw = NIN_SRC; valid = 2192 - n0 < 128 ? 2192 - n0 : 128;
            dst = (unsigned char*)(ws + WS_WIN) + (size_t)n0 * D + 128 * kb; return; }
        t -= NT_A;
        { const int w = t / NT_SQ, q = t % NT_SQ, kb = q & 15, n0 = 128 * (q >> 4);
          src = (w == 0 ? a.in[I_WPA] : (w == 1 ? a.in[I_WPB] : a.in[I_WOUT])) + (size_t)(128 * kb) * D + n0; ldw = D; valid = 128;
          dst = (unsigned char*)(ws + (w == 0 ? WS_WPA : (w == 1 ? WS_WPB : WS_WOUT))) + (size_t)n0 * D + 128 * kb; } };
    auto issue = [&](int t, int buf) {
        const float* src; int ldw, valid; unsigned char* dst; decode(t, src, ldw, valid, dst);
        int col = 4 * (F.lane & 31); col = col < valid ? col : valid - 4;
        const float* p = src + (size_t)(16 * F.wave + (F.lane >> 5)) * ldw + col;
#pragma unroll
        for (int i = 0; i < 8; ++i)
            __builtin_amdgcn_global_load_lds((const unsigned*)(p + (size_t)(2 * i) * ldw), (LAS unsigned*)(fb + buf * 65536 + (16 * F.wave + 2 * i) * 512), 16, 0, 0); };
    auto convert = [&](int buf) {
        const LAS unsigned char* s = fb + buf * 65536 + (16 * F.wave) * 512 + F.lane * 8;
        f32x2 v[16];
#pragma unroll
        for (int r = 0; r < 16; ++r) v[r] = *(const LAS f32x2*)(s + r * 512);
#pragma unroll
        for (int kq = 0; kq < 4; ++kq) { u32x2 w;
            w.x = cvt4_fp8(v[4 * kq][0] * W8_SCALE, v[4 * kq + 1][0] * W8_SCALE, v[4 * kq + 2][0] * W8_SCALE, v[4 * kq + 3][0] * W8_SCALE);
            w.y = cvt4_fp8(v[4 * kq][1] * W8_SCALE, v[4 * kq + 1][1] * W8_SCALE, v[4 * kq + 2][1] * W8_SCALE, v[4 * kq + 3][1] * W8_SCALE);
            *(LAS u32x2*)(stg + (4 * F.wave + kq) * 128 + 2 * F.lane) = w; } };
    auto store_tile = [&](int t) {
        const float* src; int ldw, valid; unsigned char* dst; decode(t, src, ldw, valid, dst);
        const int c = F.tid & 7;
#pragma unroll
        for (int j = 0; j < 2; ++j) { const int nl = (F.tid >> 3) + 64 * j; const LAS unsigned* sp = stg + (4 * c) * 128 + nl;
            u32x4 o; o.x = sp[0]; o.y = sp[128]; o.z = sp[256]; o.w = sp[384];
            *(u32x4*)(dst + (size_t)nl * D + 16 * c) = o; } };
#define WC_STEP(s_, buf_) do { if ((s_) > 0) store_tile(tix((s_) - 1)); LDS_BARRIER(); \
        asm volatile("s_waitcnt vmcnt(8)" ::: "memory"); convert(buf_); asm volatile("s_waitcnt lgkmcnt(0)" ::: "memory"); issue(tix((s_) + 2), buf_); LDS_BARRIER(); } while (0)
    const int t0 = F.vcu, nw = t0 < NTILE ? (NTILE - 1 - t0) / F.G + 1 : 0;
    if (nw > 0) {
        const int tl = t0 + (nw - 1) * F.G;
        auto tix = [&](int s) { const int x = t0 + s * F.G; return x < tl ? x : tl; };
        issue(tix(0), 0); issue(tix(1), 1);
#pragma unroll 1
        for (int s = 0; s < nw; s += 2) { WC_STEP(s, 0); WC_STEP(s + 1, 1); }
        store_tile(tl);
        VM_WAIT(); }
#undef WC_STEP
    __syncthreads();
}


__device__ __forceinline__ void p0_prologue(const Frame& F, const Args& a) {
    unsigned char* ws = a.ws;
    const int gw = F.vcu * NWAVES + F.wave, NGW = F.G * NWAVES;
    {
    LAS float* csil = (LAS float*)F.lds;
    { float cv[32];
#pragma unroll
      for (int q = 0; q < 32; ++q) cv[q] = a.in[I_C][F.tid + q * (NWAVES * 64)];
#pragma unroll
      for (int q = 0; q < 32; ++q) csil[F.tid + q * (NWAVES * 64)] = cv[q] * sigmoidf_(cv[q]); }
    __syncthreads();
    { float* MODP = (float*)(ws + WS_MODP); const float* wm = a.in[I_WMOD];
      for (int task = gw; task < KC * 192; task += NGW) { const int kc = task / 192, ch = task % 192, n = ch * 64 + F.lane, kb = kc * (D / KC);
          float acc[NB];
#pragma unroll
          for (int b = 0; b < NB; ++b) acc[b] = 0.f;
#pragma unroll 64
          for (int k = 0; k < D / KC; ++k) { const float wv = wm[(size_t)(kb + k) * (6 * D) + n];
#pragma unroll
              for (int b = 0; b < NB; ++b) acc[b] = fmaf(csil[b * D + kb + k], wv, acc[b]); }
#pragma unroll
          for (int b = 0; b < NB; ++b) MODP[((size_t)kc * NB + b) * (6 * D) + n] = acc[b]; } }
    __syncthreads(); }
    LAS float* scr = (LAS float*)(F.lds + F.wave * 18432);
    constexpr int I_IN = 16 * (NIN_A / 32);
    constexpr int I_IN8 = 16 * (NIN_B / 32);
    constexpr int I_SQ = 16 * (D / 32);
    constexpr int I_UV = 16 * 4 * 4;
    constexpr int I_RT = 32;
    constexpr int NITEMS = I_IN + I_IN8 + 3 * I_SQ + I_UV;
    for (int it = gw; it < I_UV; it += NGW) { const int r = it;
        { const int h = r / 16, q = r % 16, kb = q / 4, nb = q % 4;
          transpose_item(a.in[I_WUV] + (size_t)h * 256 * 128, 128, (bf16*)(ws + WS_WKV) + (size_t)(2048 + h * 128) * 256, 256, 64 * kb, 32 * nb, scr, F.lane, [](int np) { return np; }, a.in[I_KVG]); }
    }
    __syncthreads();
    win_conv(F, a);
    __syncthreads();
    const int gt = F.vcu * (NWAVES * 64) + F.tid, NGT = F.G * NWAVES * 64;
    { bf16* wkv = (bf16*)(ws + WS_WKV); const float* wuk = a.in[I_WUK]; const float* kvg = a.in[I_KVG];
      for (int i = gt; i < 2048 * 256 / 2; i += NGT) { const int e0 = 2 * i, c = e0 & 255; ((unsigned*)wkv)[i] = cvtpk(wuk[e0] * kvg[c], wuk[e0 + 1] * kvg[c + 1]); } }
    { bf16* wsp = (bf16*)(ws + WS_WSP); const float* w = a.in[I_WSP];
      for (int i = gt; i < 8 * 128 * 128 / 2; i += NGT) { const int e0 = 2 * i, s = e0 & 127, t = (e0 >> 7) & 127;
          ((unsigned*)wsp)[i] = cvtpk(s <= t ? w[e0] : 0.f, (s + 1) <= t ? w[e0 + 1] : 0.f); } }
    { bf16* wrt = (bf16*)(ws + WS_WRT); const float* w = a.in[I_WR];
      for (int i = gt; i < NE * D; i += NGT) { const int e = i / D, k = i % D; const float v = w[(size_t)k * NE + e]; const unsigned h = cvtpk(v, 0.f) & 0xffffu; const float r = v - bf2f((unsigned short)h);
          wrt[i] = (bf16)h; wrt[NE * D + i] = (bf16)(cvtpk(r, 0.f) & 0xffffu); } }
}

template <bool LO>
__device__ __forceinline__ void norm_mod_rows_unit(const Frame& F, const Args& a, int unit, const float* X, const float* gain, int sc_off, int sh_off, bf16* H, bf16* HLO, const float* modf, unsigned char* H8 = nullptr) {
    const int b = unit / 32, row0 = unit * 64;
    LAS float* av = (LAS float*)F.lds; LAS float* sv = av + D;
    const float* MODP = (const float*)(a.ws + WS_MODP); const float* bm = a.in[I_BMOD];
    if (modf) { const float* mf = modf + (size_t)b * (6 * D); float gk[4], sk[4], hk[4];
#pragma unroll
        for (int q = 0; q < 4; ++q) { const int k = F.tid + q * (NWAVES * 64); gk[q] = gain[k]; sk[q] = mf[sc_off + k]; hk[q] = mf[sh_off + k]; }
#pragma unroll
        for (int q = 0; q < 4; ++q) { const int k = F.tid + q * (NWAVES * 64); av[k] = gk[q] * (1.0f + sk[q]); sv[k] = hk[q]; } }
    else {
#pragma unroll
        for (int k = F.tid; k < D; k += NWAVES * 64) { float sc = bm[sc_off + k], sh = bm[sh_off + k];
#pragma unroll
            for (int kc = 0; kc < KC; ++kc) { const float* p = MODP + ((size_t)kc * NB + b) * (6 * D); sc += p[sc_off + k]; sh += p[sh_off + k]; }
            av[k] = gain[k] * (1.0f + sc); sv[k] = sh; } }
    __syncthreads();
    for (int rr = F.wave * 2; rr < 64; rr += NWAVES * 2) {
        f32x4 v[2][8]; float s[2] = {0.f, 0.f};
#pragma unroll
        for (int q = 0; q < 2; ++q) { const f32x4* xr = (const f32x4*)(X + (size_t)(row0 + rr + q) * D) + F.lane;
#pragma unroll
            for (int j = 0; j < 8; ++j) v[q][j] = xr[64 * j]; }
#pragma unroll
        for (int q = 0; q < 2; ++q)
#pragma unroll
            for (int j = 0; j < 8; ++j) s[q] += (v[q][j][0] * v[q][j][0] + v[q][j][1] * v[q][j][1]) + (v[q][j][2] * v[q][j][2] + v[q][j][3] * v[q][j][3]);
#pragma unroll
        for (int q = 0; q < 2; ++q) { const int row = row0 + rr + q;
            const float rstd = 1.0f / sqrtf(wave_sum(s[q]) * (1.0f / D) + EPS);
            u32x2* o8 = (u32x2*)(H + (size_t)row * D) + F.lane; u32x2* l8 = (u32x2*)(HLO + (size_t)row * D) + F.lane;
#pragma unroll
            for (int j = 0; j < 8; ++j) { const f32x4 aa = ((const LAS f32x4*)av)[F.lane + 64 * j], ss = ((const LAS f32x4*)sv)[F.lane + 64 * j];
                const f32x4 y = (v[q][j] * rstd) * aa + ss; u32x2 w; w.x = cvtpk(y[0], y[1]); w.y = cvtpk(y[2], y[3]); if (H) o8[64 * j] = w;
                if (H8) ((unsigned*)(H8 + (size_t)row * D))[F.lane + 64 * j] = cvt4_fp8(y[0], y[1], y[2], y[3]);
                if (LO) { u32x2 l; l.x = cvtpk(y[0] - bflo(w.x), y[1] - bfhi(w.x)); l.y = cvtpk(y[2] - bflo(w.y), y[3] - bfhi(w.y)); l8[64 * j] = l; } } }
    }
    __syncthreads();
}

__device__ __forceinline__ void idx_scores_unit(const Frame& F, const Args& a, int b, int qt) {
    const bf16* QI = (const bf16*)(a.ws + WS_QI); const bf16* KI = (const bf16*)(a.ws + WS_KI); const float* WI = (const float*)(a.ws + WS_WI); float* SC = (float*)(a.ws + WS_SC);
    const int lane = F.lane, i = lane & 31, kg = lane >> 5;
    const int qbase = qt * 32 + 4 * F.wave;
    const int head = (i & 3) + 4 * (i >> 3), qsel = (i >> 2) & 1;
    bf16x8 af[2][8]; float w[2][16];
#pragma unroll
    for (int p = 0; p < 2; ++p) {
        const bf16* src = QI + (size_t)(b * SEQ + qbase + 2 * p + qsel) * D + head * 128 + kg * 8;
#pragma unroll
        for (int ks = 0; ks < 8; ++ks) af[p][ks] = *(const bf16x8*)(src + ks * 16);
        const float* wp = WI + (size_t)(b * SEQ + qbase + 2 * p + kg) * 16;
#pragma unroll
        for (int r4 = 0; r4 < 4; ++r4) { const f32x4 t = *(const f32x4*)(wp + 4 * r4); w[p][4 * r4] = t[0]; w[p][4 * r4 + 1] = t[1]; w[p][4 * r4 + 2] = t[2]; w[p][4 * r4 + 3] = t[3]; }
    }
    const int kend = 64 * ((qt * 32) / 64 + 1), ntile = kend / 32;
    constexpr int KPITCH = 272, KBUF = 32 * KPITCH;
    LAS char* kl = (LAS char*)F.lds;
    const bf16* kg_src = KI + (size_t)(b * SEQ + (F.tid >> 4)) * 128 + (F.tid & 15) * 8;
    const int kl_dst = (F.tid >> 4) * KPITCH + (F.tid & 15) * 16, kl_src = i * KPITCH + kg * 16;
    LAS float* swin = (LAS float*)(F.lds + 32768 + F.wave * 4096);
#pragma unroll
    for (int p = 0; p < 2; ++p) {
#pragma unroll
        for (int ks = 0; ks < 8; ++ks) asm volatile("" :: "v"(af[p][ks]));
#pragma unroll
        for (int r = 0; r < 16; ++r) asm volatile("" :: "v"(w[p][r])); }
    bf16x8 r0, r1;
#define IDX_GLOAD(dst, t_) asm volatile("global_load_dwordx4 %0, %1, off" : "=v"(dst) : "v"(kg_src + (size_t)((t_) * 32) * 128) : "memory")
    { const bf16x8 t0 = *(const bf16x8*)kg_src; *(LAS bf16x8*)(kl + kl_dst) = t0; }
    IDX_GLOAD(r0, 1);
    LDS_BARRIER();
#define IDX_STEP(t, RCUR, RNXT) do {                                                                                               \
        if ((t) + 2 < ntile) IDX_GLOAD(RNXT, (t) + 2);                                                                             \
        bf16x8 bfr[8];                                                                                                             \
        _Pragma("unroll") for (int ks = 0; ks < 8; ++ks) bfr[ks] = *(const LAS bf16x8*)(kl + ((t) & 1) * KBUF + kl_src + ks * 32);  \
        _Pragma("unroll") for (int p = 0; p < 2; ++p) { f32x16 acc = {};                                                           \
            _Pragma("unroll") for (int ks = 0; ks < 8; ++ks) acc = __builtin_amdgcn_mfma_f32_32x32x16_bf16(af[p][ks], bfr[ks], acc, 0, 0, 0); \
            float sc_ = 0.f;                                                                                                       \
            _Pragma("unroll") for (int r = 0; r < 16; ++r) sc_ = fmaf(fmaxf(acc[r], 0.f), w[p][r], sc_);                            \
            swin[(2 * p + kg) * 256 + ((t) & 7) * 32 + i] = sc_; }                 \
        if ((t) + 1 < ntile) { if ((t) + 2 < ntile) asm volatile("s_waitcnt vmcnt(1)" ::: "memory"); else asm volatile("s_waitcnt vmcnt(0)" ::: "memory"); \
            *(LAS bf16x8*)(kl + (((t) + 1) & 1) * KBUF + kl_dst) = RCUR; }                                                        \
        if (((t) & 7) == 7 || (t) == ntile - 1) {                                \
            const int w0 = ((t) & ~7) * 32; f32x4 fl[4];                                                                           \
            _Pragma("unroll") for (int q = 0; q < 4; ++q) fl[q] = *(const LAS f32x4*)(swin + q * 256 + 4 * lane);                  \
            _Pragma("unroll") for (int q = 0; q < 4; ++q) *(f32x4*)(SC + (size_t)(b * SEQ + qbase + q) * SEQ + w0 + 4 * lane) = fl[q]; } \
        LDS_BARRIER(); } while (0)
    for (int t = 0; t < ntile; t += 2) { IDX_STEP(t, r0, r1); IDX_STEP(t + 1, r1, r0); }
#undef IDX_STEP
#undef IDX_GLOAD
    VM_WAIT(); __syncthreads();
}

__device__ __forceinline__ void topk_mask_row(const Frame& F, const Args& a, int t) {
    const float* SC = (const float*)(a.ws + WS_SC) + (size_t)t * SEQ; unsigned* MK = (unsigned*)(a.ws + WS_MASK) + (size_t)t * 64;
    const int s = t & (SEQ - 1), nj = s / 64 + 1;
    if (nj * 64 <= KSEL) { MK[F.lane] = (F.lane * 32 < nj * 64) ? 0xffffffffu : 0u; return; }
    unsigned u[32];
    { float raw[32];
#pragma unroll
      for (int j = 0; j < 32; ++j) raw[j] = SC[(j < nj ? j : nj - 1) * 64 + F.lane];
#pragma unroll
      for (int j = 0; j < 32; ++j) { const unsigned bits = __float_as_uint(raw[j]); const unsigned key = bits ^ ((unsigned)((int)bits >> 31) | 0x80000000u); const unsigned keep = (unsigned)-(int)(j < nj); u[j] = key & keep; } }
    constexpr int LOWB = 18;
    unsigned prefix = 0u; int cntp = 0; bool done = false;
    for (int bit = 31; bit >= LOWB; --bit) { const unsigned cand = prefix | (1u << bit); int cnt = 0;
#pragma unroll
        for (int c8 = 0; c8 < 4; ++c8) if (nj > 8 * c8) {
#pragma unroll
            for (int j = 8 * c8; j < 8 * c8 + 8; ++j) cnt += __builtin_popcountll(__ballot(u[j] >= cand)); }
        if (cnt >= KSEL) { prefix = cand; cntp = cnt; if (cnt == KSEL) { done = true; break; } } }
    if (!done) {
        if (cntp == 0) { cntp = 0;
#pragma unroll
            for (int j = 0; j < 32; ++j) cntp += __builtin_popcountll(__ballot(u[j] >= 1u)); }
        const unsigned hic = prefix + (1u << LOWB); int cnt_hi = 0;
        if (hic > prefix) {
#pragma unroll
            for (int c8 = 0; c8 < 4; ++c8) if (nj > 8 * c8) {
#pragma unroll
                for (int j = 8 * c8; j < 8 * c8 + 8; ++j) cnt_hi += __builtin_popcountll(__ballot(u[j] >= hic)); } }
        const int namb = cntp - cnt_hi;
        if (namb <= 128) {
            LAS unsigned* cb = (LAS unsigned*)(F.lds + 98304 + F.wave * 512); int base = 0;
#pragma unroll
            for (int j = 0; j < 32; ++j) { const bool amb = (u[j] - prefix) < (1u << LOWB) && u[j] >= prefix; const unsigned long long mk = __ballot(amb);
                const int pos = base + (int)__builtin_amdgcn_mbcnt_hi((unsigned)(mk >> 32), __builtin_amdgcn_mbcnt_lo((unsigned)mk, 0u));
                if (amb) cb[pos] = u[j];
                base += __builtin_popcountll(mk); }
            const unsigned c0 = F.lane < namb ? cb[F.lane] : 0u, c1 = F.lane + 64 < namb ? cb[F.lane + 64] : 0u;
            for (int bit = LOWB - 1; bit >= 0; --bit) { const unsigned cand = prefix | (1u << bit);
                const int cnt = cnt_hi + __builtin_popcountll(__ballot(c0 >= cand)) + __builtin_popcountll(__ballot(c1 >= cand));
                if (cnt >= KSEL) { prefix = cand; if (cnt == KSEL) break; } }
        } else {
            for (int bit = LOWB - 1; bit >= 0; --bit) { const unsigned cand = prefix | (1u << bit); int cnt = 0;
#pragma unroll
                for (int c8 = 0; c8 < 4; ++c8) if (nj > 8 * c8) {
#pragma unroll
                    for (int j = 8 * c8; j < 8 * c8 + 8; ++j) cnt += __builtin_popcountll(__ballot(u[j] >= cand)); }
                if (cnt >= KSEL) { prefix = cand; if (cnt == KSEL) break; } } }
    }
#pragma unroll
    for (int j = 0; j < 32; ++j) { const unsigned long long bal = __ballot(u[j] >= prefix);
        if (F.lane == 0) { u32x2 w; w.x = (unsigned)bal; w.y = (unsigned)(bal >> 32); *(u32x2*)(MK + 2 * j) = w; } }
}

__device__ __forceinline__ void spatial_group(const Frame& F, const Args& a, int b, int n, int gh) {
    using namespace att;
    const bf16* V = (const bf16*)(a.ws + WS_V); const bf16* U = (const bf16*)(a.ws + WS_U); unsigned char* SG8 = (unsigned char*)(a.ws + WS_SG);
    char* lds = (char*)F.lds;
    const int tid = F.tid, lane = F.lane, r32 = lane & 31, hi = lane >> 5, tt = F.wave & 3, dh = F.wave >> 2;
    const int tok0 = b * SEQ + n * 128, sr = tid >> 4, sc = (tid & 15) * 8;
    LAS f32x2* stat = (LAS f32x2*)(lds + 4 * SHM_V);
    { const int row = tid >> 2, q = tid & 3; const f32x4* p = (const f32x4*)((const float*)(a.ws + WS_VST) + ((size_t)(tok0 + row) * 32 + q * 8) * 2);
      const f32x4 p0 = p[0], p1 = p[1], p2 = p[2], p3 = p[3];
      float s1 = (p0[0] + p0[2]) + (p1[0] + p1[2]) + (p2[0] + p2[2]) + (p3[0] + p3[2]), s2 = (p0[1] + p0[3]) + (p1[1] + p1[3]) + (p2[1] + p2[3]) + (p3[1] + p3[3]);
      s1 += __shfl_xor(s1, 1); s1 += __shfl_xor(s1, 2); s2 += __shfl_xor(s2, 1); s2 += __shfl_xor(s2, 2);
      const float mean = s1 * (1.0f / D), var = fmaxf(s2 * (1.0f / D) - mean * mean, 0.f);
      if (q == 0) stat[row] = (f32x2){mean, 1.0f / sqrtf(var + EPS)}; }
    bf16x8 xr[4][2]; f32x4 gn[2][2];
#define SP_LOAD(g_) do { _Pragma("unroll") for (int tl = 0; tl < 4; ++tl) { const int dhh = tl >> 1, kh = tl & 1; const bf16* src = V + (size_t)(tok0 + 64 * kh) * D + (g_) * 256 + 128 * dhh + sc; \
          xr[tl][0] = *(const bf16x8*)(src + (size_t)sr * D); xr[tl][1] = *(const bf16x8*)(src + (size_t)(32 + sr) * D); } \
      _Pragma("unroll") for (int dhh = 0; dhh < 2; ++dhh) { const float* gp = a.in[I_SGG] + (g_) * 256 + 128 * dhh + sc; gn[dhh][0] = *(const f32x4*)gp; gn[dhh][1] = *(const f32x4*)(gp + 4); } } while (0)
    SP_LOAD(4 * gh);
    const int vb0 = (int)(uintptr_t)lds + v_rd_base(lane);
#pragma unroll 1
    for (int i = 0; i < 4; ++i) { const int g = 4 * gh + i;
        const bf16* WSP = (const bf16*)(a.ws + WS_WSP) + (size_t)g * 128 * 128; const float* bsp = a.in[I_BSP] + g * 128;
        bf16x8 pa[8];
        { const bf16* wp = WSP + (size_t)(32 * tt + r32) * 128 + 8 * hi;
#pragma unroll
          for (int ks = 0; ks < 8; ++ks) pa[ks] = *(const bf16x8*)(wp + 16 * ks); }
        LDS_BARRIER();
#pragma unroll
        for (int tl = 0; tl < 4; ++tl) { const int dhh = tl >> 1, kh = tl & 1;
#pragma unroll
            for (int h2 = 0; h2 < 2; ++h2) { const int rl = 64 * kh + 32 * h2 + sr; const f32x2 ms = stat[rl]; f32x4 x0, x1; pg8::unpack8(__builtin_bit_cast(u32x4, xr[tl][h2]), x0, x1);
                const f32x4 y0 = (x0 - ms.x) * ms.y * gn[dhh][0], y1 = (x1 - ms.x) * ms.y * gn[dhh][1];
#pragma unroll
                for (int d0 = 0; d0 < 4; ++d0) *(unsigned*)(lds + tl * SHM_V + v_st(32 * h2 + sr, d0 * 32 + (sc >> 2))) = cvtpk(y0[d0], y1[d0]); } }
        SP_LOAD(i < 3 ? g + 1 : g);
        LDS_BARRIER();
        f32x16 o[4] = {};
        if (dh == 0) { pv_tile<0>(o, vb0, pa[0], pa[1], pa[2], pa[3]); pv_tile<1>(o, vb0, pa[4], pa[5], pa[6], pa[7]); }
        else         { pv_tile<2>(o, vb0, pa[0], pa[1], pa[2], pa[3]); pv_tile<3>(o, vb0, pa[4], pa[5], pa[6], pa[7]); }
        float bb[16]; u32x2 uu[16];
#pragma unroll
        for (int r = 0; r < 16; ++r) { const int tl = 32 * tt + crow(r, hi); bb[r] = bsp[tl]; uu[r] = *(const u32x2*)(U + (size_t)(tok0 + tl) * D + g * 256 + dh * 128 + 4 * r32); }
#pragma unroll
        for (int r = 0; r < 16; ++r) { const int tl = 32 * tt + crow(r, hi); const size_t rowoff = (size_t)(tok0 + tl) * D + g * 256 + dh * 128 + 4 * r32;
            *(unsigned*)(SG8 + rowoff) = cvt4_fp8((o[0][r] + bb[r]) * bflo(uu[r].x), (o[1][r] + bb[r]) * bfhi(uu[r].x), (o[2][r] + bb[r]) * bflo(uu[r].y), (o[3][r] + bb[r]) * bfhi(uu[r].y)); }
    }
#undef SP_LOAD
    __syncthreads();
}

__device__ __forceinline__ att::BlockRef attn_ref(const Args& a, int item, int pass) {
    const int bh = item >> 2, x = item & 3, b = bh >> 4, h = bh & 15, qb = pass ? 7 - x : x;
    att::BlockRef r; const size_t base = (size_t)(b * SEQ) * D + h * 128;
    r.Q = (const bf16*)(a.ws + WS_Q) + base + (size_t)(qb * 256) * D; r.O = (bf16*)((unsigned char*)(a.ws + WS_OA) + base + (size_t)(qb * 256) * D);
    r.K = (const bf16*)(a.ws + WS_KH) + base; r.V = (const bf16*)(a.ws + WS_VH) + base;
    r.M = (const unsigned*)(a.ws + WS_MASK) + (size_t)(b * SEQ + qb * 256) * 64; r.P0 = qb * 256;
    return r;
}
__device__ __forceinline__ void attn_phase(const Frame& F, const Args& a) {
    constexpr int NITEMS = NB * 16 * 4;
    int L = F.vcu; if (L >= NITEMS) return;
    int pass = 0; att::BlockRef cur = attn_ref(a, L, 0); att::Seam S;
    att::attn_prime(cur, (char*)F.lds, S);
    for (;;) {
        const bool more_pass = pass == 0, more_item = L + F.G < NITEMS, last = !more_pass && !more_item;
        int Ln = L, passn = pass + 1; if (!more_pass) { passn = 0; Ln = more_item ? L + F.G : L; }
        const att::BlockRef nxt = last ? cur : attn_ref(a, Ln, passn);
        att::attn_block(cur, nxt, (char*)F.lds, S);
        if (last) break;
        cur = nxt; L = Ln; pass = passn;
    }
    VM_WAIT(); __syncthreads();
}

__device__ __forceinline__ void router_unit(const Frame& F, const Args& a, int unit) {
    const int b = unit / 32, row0 = unit * 64, lane = F.lane, wave = F.wave, r32 = lane & 31, hi = lane >> 5, l16 = lane & 15, kg = lane >> 4;
    constexpr int RP = 4112;
    LAS char* hiL = (LAS char*)F.lds; LAS char* loL = hiL + 16 * RP;
    LAS float* part = (LAS float*)F.lds;
    LAS float* logit = (LAS float*)(F.lds + 2 * 16 * RP);
    LAS int* hist = (LAS int*)(F.lds + 2 * 16 * RP + 2048);
    const float* X1 = (const float*)(a.ws + WS_X1); unsigned char* H8 = (unsigned char*)(a.ws + WS_H2F8);
    const bf16* WH = (const bf16*)(a.ws + WS_WRT); const bf16* WL = WH + NE * D;
    f32x4 av[8], sv[8];
    { const float* mf = (const float*)(a.ws + WS_MODF) + (size_t)b * (6 * D); const float* gn = a.in[I_N2G];
#pragma unroll
      for (int j = 0; j < 8; ++j) { const int k = 4 * (lane + 64 * j); const f32x4 g4 = *(const f32x4*)(gn + k), sc = *(const f32x4*)(mf + 4 * D + k); sv[j] = *(const f32x4*)(mf + 3 * D + k); av[j] = g4 * (sc + 1.0f); } }
    const float br = a.in[I_BR][F.tid & 31];
    if (F.tid < NE) hist[F.tid] = 0;
#pragma unroll 1
    for (int grp = 0; grp < 4; ++grp) {
        { f32x4 v[2][8]; float ss[2] = {0.f, 0.f};
#pragma unroll
          for (int q = 0; q < 2; ++q) { const f32x4* xr = (const f32x4*)(X1 + (size_t)(row0 + 16 * grp + 2 * wave + q) * D) + lane;
#pragma unroll
              for (int j = 0; j < 8; ++j) v[q][j] = xr[64 * j]; }
#pragma unroll
          for (int q = 0; q < 2; ++q)
#pragma unroll
              for (int j = 0; j < 8; ++j) ss[q] += (v[q][j][0] * v[q][j][0] + v[q][j][1] * v[q][j][1]) + (v[q][j][2] * v[q][j][2] + v[q][j][3] * v[q][j][3]);
#pragma unroll
          for (int q = 0; q < 2; ++q) { const int rl = 2 * wave + q; const size_t row = (size_t)(row0 + 16 * grp + rl);
              const float rstd = 1.0f / sqrtf(wave_sum(ss[q]) * (1.0f / D) + EPS);
#pragma unroll
              for (int j = 0; j < 8; ++j) { const f32x4 y = (v[q][j] * rstd) * av[j] + sv[j];
                  ((unsigned*)(H8 + row * D))[lane + 64 * j] = cvt4_fp8(y[0], y[1], y[2], y[3]);
                  u32x2 w; w.x = cvtpk(y[0], y[1]); w.y = cvtpk(y[2], y[3]);
                  u32x2 l; l.x = cvtpk(y[0] - bflo(w.x), y[1] - bfhi(w.x)); l.y = cvtpk(y[2] - bflo(w.y), y[3] - bfhi(w.y));
                  *(LAS u32x2*)(hiL + rl * RP + (lane + 64 * j) * 8) = w; *(LAS u32x2*)(loL + rl * RP + (lane + 64 * j) * 8) = l; } } }
        LDS_BARRIER();
        f32x4 acc[2] = {{0.f, 0.f, 0.f, 0.f}, {0.f, 0.f, 0.f, 0.f}};
#pragma unroll 1
        for (int kb = 0; kb < 2; ++kb) { bf16x8 bh[4][2], bl[4][2];
#pragma unroll
            for (int ks = 0; ks < 4; ++ks)
#pragma unroll
                for (int nt = 0; nt < 2; ++nt) { const size_t o = (size_t)(l16 + 16 * nt) * D + 256 * wave + 32 * (4 * kb + ks) + 8 * kg; bh[ks][nt] = *(const bf16x8*)(WH + o); bl[ks][nt] = *(const bf16x8*)(WL + o); }
#pragma unroll
            for (int ks = 0; ks < 4; ++ks) { const int ko = (256 * wave + 32 * (4 * kb + ks) + 8 * kg) * 2;
                const bf16x8 ah = *(const LAS bf16x8*)(hiL + l16 * RP + ko), al = *(const LAS bf16x8*)(loL + l16 * RP + ko);
#pragma unroll
                for (int nt = 0; nt < 2; ++nt) { acc[nt] = __builtin_amdgcn_mfma_f32_16x16x32_bf16(ah, bh[ks][nt], acc[nt], 0, 0, 0);
                    acc[nt] = __builtin_amdgcn_mfma_f32_16x16x32_bf16(ah, bl[ks][nt], acc[nt], 0, 0, 0);
                    acc[nt] = __builtin_amdgcn_mfma_f32_16x16x32_bf16(al, bh[ks][nt], acc[nt], 0, 0, 0); } } }
        LDS_BARRIER();
#pragma unroll
        for (int nt = 0; nt < 2; ++nt)
#pragma unroll
            for (int j = 0; j < 4; ++j) part[(wave * 16 + 4 * kg + j) * 32 + 16 * nt + l16] = acc[nt][j];
        LDS_BARRIER();
        { const int rr = F.tid >> 5, e = F.tid & 31; float sum = br;
#pragma unroll
          for (int wv = 0; wv < 8; ++wv) sum += part[(wv * 16 + rr) * 32 + e];
          logit[rr * 32 + e] = sum; }
        LDS_BARRIER();
        { const int rl = 2 * wave + hi, t = row0 + 16 * grp + rl; float v = logit[rl * 32 + r32]; int ei[4]; float ev[4];
#pragma unroll
          for (int k = 0; k < 4; ++k) { float m = v;
#pragma unroll
              for (int o = 1; o < 32; o <<= 1) m = fmaxf(m, __shfl_xor(m, o));
              const unsigned long long bal = __ballot(v == m); const unsigned mine = hi ? (unsigned)(bal >> 32) : (unsigned)bal; const int bi = __ffs(mine) - 1;
              ei[k] = bi; ev[k] = m; if (r32 == bi) v = -__builtin_inff(); }
          if (r32 == 0) { float ex[4], sum = 0.f;
#pragma unroll
              for (int k = 0; k < 4; ++k) { ex[k] = __expf(ev[k] - ev[0]); sum += ex[k]; }
              int* TE = (int*)(a.ws + WS_ROUTE + RT_TOPE) + (size_t)t * 4; float* TG = (float*)(a.ws + WS_ROUTE + RT_TOPG) + (size_t)t * 4; const float inv = 1.0f / sum;
              *(int4*)TE = make_int4(ei[0], ei[1], ei[2], ei[3]); *(f32x4*)TG = (f32x4){ex[0] * inv, ex[1] * inv, ex[2] * inv, ex[3] * inv};
#pragma unroll
              for (int k = 0; k < 4; ++k) atomicAdd((int*)&hist[ei[k]], 1); } }
    }
    __syncthreads();
    if (F.tid < NE) ((int*)(a.ws + WS_ROUTE + RT_HIST))[unit * NE + F.tid] = hist[F.tid];
    __syncthreads();
}

__device__ __forceinline__ void route_unit(const Frame& F, const Args& a, int unit) {
    const int* HIST = (const int*)(a.ws + WS_ROUTE + RT_HIST); const int* TE = (const int*)(a.ws + WS_ROUTE + RT_TOPE) + (size_t)unit * 256; const float* TG = (const float*)(a.ws + WS_ROUTE + RT_TOPG) + (size_t)unit * 256;
    int* POS = (int*)(a.ws + WS_ROUTE + RT_POS) + (size_t)unit * 256; float* RG = (float*)(a.ws + WS_ROUTE + RT_GATE);
    LAS int* cnt = (LAS int*)F.lds; LAS int* before = cnt + 32; LAS int* pstart = cnt + 64; LAS int* te = cnt + 128; LAS int* posl = cnt + 384;
    { LAS int* hl = cnt + 1024;
      { int hv[16];
#pragma unroll
        for (int q = 0; q < 16; ++q) hv[q] = HIST[F.tid + q * (NWAVES * 64)];
#pragma unroll
        for (int q = 0; q < 16; ++q) hl[F.tid + q * (NWAVES * 64)] = hv[q]; }
      __syncthreads();
      if (F.tid < NE) { int c = 0, bf = 0; for (int u2 = 0; u2 < T / 64; ++u2) { const int h = hl[u2 * NE + F.tid]; c += h; if (u2 < unit) bf += h; } cnt[F.tid] = c; before[F.tid] = bf; } }
    if (F.tid < 256) te[F.tid] = TE[F.tid];
    __syncthreads();
    if (F.tid == 0) { int run = 0; for (int e = 0; e < NE; ++e) { pstart[e] = run; run += ((cnt[e] + 255) >> 8) << 8; }
        if (unit == 0) { int* TILE = (int*)(a.ws + WS_ROUTE + RT_TILE); int mt = 0; for (int e = 0; e < NE; ++e) { const int ntile = (cnt[e] + 255) >> 8; for (int q = 0; q < ntile; ++q) TILE[mt++] = e; }
            *(int*)(a.ws + WS_ROUTE + RT_NMT) = mt; } }
    __syncthreads();
    if (F.tid < NE) { int run = pstart[F.tid] + before[F.tid]; for (int sl = 0; sl < 256; ++sl) if (te[sl] == F.tid) posl[sl] = run++; }
    __syncthreads();
    if (F.tid < 256) { const int p = posl[F.tid]; POS[F.tid] = p; RG[p] = TG[F.tid]; ((int*)(a.ws + WS_ROUTE + RT_TOK))[p] = unit * 64 + (F.tid >> 2); }
    __syncthreads();
}

template <bool MOE>
__device__ __forceinline__ void final_rows(const Frame& F, const Args& a, int gw, int NGW) {
    const float* X1 = (const float*)(a.ws + WS_X1); const int* POS = (const int*)(a.ws + WS_ROUTE + RT_POS); const bf16* YS = (const bf16*)(a.ws + WS_YS);
    f32x4 fg[8];
#pragma unroll
    for (int j = 0; j < 8; ++j) fg[j] = ((const f32x4*)a.in[I_FG])[F.lane + 64 * j];
    int row = gw; if (row >= T) return;
    f32x4 v[8]; int4 pos = make_int4(0, 0, 0, 0);
#pragma unroll
    for (int j = 0; j < 8; ++j) v[j] = ((const f32x4*)(X1 + (size_t)row * D))[F.lane + 64 * j];
    if (MOE) pos = *(const int4*)(POS + (size_t)row * 4);
    for (; row < T; row += NGW) {
        f32x4 m[8];
#pragma unroll
        for (int j = 0; j < 8; ++j) m[j] = (f32x4){0.f, 0.f, 0.f, 0.f};
        f32x4 g2[8];
        if (MOE) {
            const int pk[4] = {__builtin_amdgcn_readfirstlane(pos.x), __builtin_amdgcn_readfirstlane(pos.y), __builtin_amdgcn_readfirstlane(pos.z), __builtin_amdgcn_readfirstlane(pos.w)};
            u32x2 ys[4][8];
#pragma unroll
            for (int k = 0; k < 4; ++k)
#pragma unroll
                for (int j = 0; j < 8; ++j) ys[k][j] = ((const u32x2*)(YS + (size_t)pk[k] * D))[F.lane + 64 * j];
#pragma unroll
            for (int j = 0; j < 8; ++j) g2[j] = ((const f32x4*)((const float*)(a.ws + WS_MODF) + (size_t)(row / SEQ) * (6 * D) + 5 * D))[F.lane + 64 * j];
#pragma unroll
            for (int k = 0; k < 4; ++k)
#pragma unroll
                for (int j = 0; j < 8; ++j) { const u32x2 w = ys[k][j]; m[j] += (f32x4){bflo(w.x), bfhi(w.x), bflo(w.y), bfhi(w.y)}; }
        }
        const int nrow = row + NGW; f32x4 vn[8]; int4 posn = pos;
        if (nrow < T) {
#pragma unroll
            for (int j = 0; j < 8; ++j) vn[j] = ((const f32x4*)(X1 + (size_t)nrow * D))[F.lane + 64 * j];
            if (MOE) posn = *(const int4*)(POS + (size_t)nrow * 4); }
        if (MOE) {
#pragma unroll
            for (int j = 0; j < 8; ++j) v[j] += g2[j] * m[j]; }
        float ss = 0.f;
#pragma unroll
        for (int j = 0; j < 8; ++j) ss += (v[j][0] * v[j][0] + v[j][1] * v[j][1]) + (v[j][2] * v[j][2] + v[j][3] * v[j][3]);
        const float rstd = 1.0f / sqrtf(wave_sum(ss) * (1.0f / D) + EPS);
        f32x4* o = (f32x4*)(a.out + (size_t)row * D) + F.lane;
#pragma unroll
        for (int j = 0; j < 8; ++j) o[64 * j] = v[j] * rstd * fg[j];
        if (nrow < T) {
#pragma unroll
            for (int j = 0; j < 8; ++j) v[j] = vn[j];
            pos = posn; }
    }
}

constexpr int N_PHASES = 13;
constexpr int N_LAUNCHES = MK_N_LAUNCHES;

__global__ void __launch_bounds__(NWAVES * 64, 2) fwd_kernel(Args args) {
    extern __shared__ __attribute__((aligned(16))) unsigned char lds_raw[];
    Frame F;
    F.lds = (LAS unsigned char*)lds_raw;
    F.tid = threadIdx.x; F.lane = F.tid & 63; F.wave = __builtin_amdgcn_readfirstlane(F.tid >> 6);
    F.G = gridDim.x; { const int bx = blockIdx.x; F.vcu = (F.G % 8 == 0) ? (bx % 8) * (F.G / 8) + bx / 8 : bx; }
    volatile LAS unsigned* MISC = (volatile LAS unsigned*)(F.lds + MISC_OFF);
    for (int u = F.tid; u < (LDS_BYTES - LDSCTL_OFF) / 4; u += NWAVES * 64) ((LAS unsigned*)(F.lds + LDSCTL_OFF))[u] = 0u;
    __syncthreads();
    unsigned char* ws = args.ws;
    unsigned* barw = (unsigned*)(ws + WS_CTL) + CW_BAR;
    XcdBarrier bar; bar.bar = barw; bar.x = 0; bar.st = nullptr;
    if (N_LAUNCHES == 1) bar = xcd_barrier_post(barw, MISC + 8);
    const int lo = args.ph_lo, hi = args.ph_hi;
#ifndef PH_MASK
#define PH_MASK 0xffff
#endif
#define IN(k) (((PH_MASK >> (k)) & 1) && lo <= (k) && (k) < hi)
#define SEAM(k) do { if (IN(k) && IN((k) + 1)) xcd_barrier(bar); } while (0)
    const int gw = F.vcu * NWAVES + F.wave, NGW = F.G * NWAVES;
    const int NUNIT64 = T / 64;

    if (IN(0)) { p0_prologue(F, args); }

    SEAM(0);
    if (IN(1)) {
        for (int u = F.vcu; u < NUNIT64; u += F.G) norm_mod_rows_unit<false>(F, args, u, args.in[I_X], args.in[I_N1G], 1 * D, 0 * D, nullptr, nullptr, nullptr, (unsigned char*)(ws + WS_H1F8));
        { const float* MODP = (const float*)(ws + WS_MODP); float* MODF = (float*)(ws + WS_MODF); const float* bm = args.in[I_BMOD];
          for (int i = F.vcu * (NWAVES * 64) + F.tid; i < NB * 6 * D; i += F.G * NWAVES * 64) { const int b = i / (6 * D), n = i % (6 * D); float s = bm[n];
#pragma unroll
              for (int kc = 0; kc < KC; ++kc) s += MODP[((size_t)kc * NB + b) * (6 * D) + n];
              MODF[i] = s; } }
    }

    SEAM(1);
    if (IN(2)) {
        { pg8::Gemm g{(const bf16*)(ws + WS_H1F8), (const bf16*)(ws + WS_WIN8), D}; pg8::UnevenOrder S; S.init(T, NIN_B, F.G, (int)blockIdx.x);
          pg8::EpiG1b E{ws};
          pg8::gemm_phase<pg8::EpiG1b, pg8::UnevenOrder, true>(F.lds, g, S, E); }
        pg8::Gemm g{(const bf16*)(ws + WS_H1F8), (const bf16*)(ws + WS_WIN), D}; pg8::StaticOrder S; S.init(T, NIN_A, F.G, (int)blockIdx.x);
        pg8::EpiG1 E{(bf16*)(ws + WS_QI), (bf16*)(ws + WS_KI), (float*)(ws + WS_WI)};
        pg8::gemm_phase<pg8::EpiG1, pg8::StaticOrder, true>(F.lds, g, S, E);
    }

    SEAM(2);
    if (IN(3)) {
        { pg8::Gemm g{(const bf16*)(ws + WS_CKV), (const bf16*)(ws + WS_WKV), 256}; pg8::StaticOrder S; S.init(T, 4096, F.G, (int)blockIdx.x);
          pg8::EpiKV E{(bf16*)(ws + WS_KH), (bf16*)(ws + WS_VH), (const float*)(ws + WS_SSQ)};
          pg8::gemm_phase<pg8::EpiKV, pg8::StaticOrder>(F.lds, g, S, E); }

        for (int it = F.vcu; it < 256; it += F.G) { const int b = it >> 5, x = it & 31;
#pragma unroll 1
            for (int pass = 0; pass < 2; ++pass) { const int qt = pass ? 63 - x : x;
                idx_scores_unit(F, args, b, qt);
                for (int q = 0; q < 4; ++q) topk_mask_row(F, args, b * SEQ + qt * 32 + 4 * F.wave + q);
                } }

        for (int u = F.vcu; u < NB * 16 * 2; u += F.G) spatial_group(F, args, u >> 5, (u >> 1) & 15, u & 1);

    }
    SEAM(4);
    if (IN(5)) {
        const bool conv_first = (blockIdx.x & 1) == 0;
        if (conv_first) moe_conv(F, args);
#ifndef NO_ATTN
        attn_phase(F, args);
#endif

#ifndef NO_YB
        { pg8::Gemm g{(const bf16*)(ws + WS_SG), (const bf16*)(ws + WS_WPB), D}; pg8::StaticOrder S; S.init(T, D, F.G, (int)blockIdx.x);
          pg8::EpiGate<false> E{(const bf16*)(ws + WS_GB), nullptr, (void*)(ws + WS_YB)};
          pg8::gemm_phase<pg8::EpiGate<false>, pg8::StaticOrder, true>(F.lds, g, S, E); }
#endif
        if (!conv_first) { __syncthreads(); moe_conv(F, args); }

    }
    SEAM(5);
    if (IN(6)) {
        pg8::Gemm g{(const bf16*)(ws + WS_OA), (const bf16*)(ws + WS_WPA), D}; pg8::StaticOrder S; S.init(T, D, F.G, (int)blockIdx.x);
        pg8::EpiGate<true> E{(const bf16*)(ws + WS_GA), (const bf16*)(ws + WS_YB), (void*)(ws + WS_MIX)};
        pg8::gemm_phase<pg8::EpiGate<true>, pg8::StaticOrder, true>(F.lds, g, S, E);
    }

    SEAM(6);
    if (IN(7)) {
        pg8::Gemm g{(const bf16*)(ws + WS_MIX), (const bf16*)(ws + WS_WOUT), D}; pg8::StaticOrder S; S.init(T, D, F.G, (int)blockIdx.x);
        pg8::EpiX1 E{args.in[I_X], (const float*)(ws + WS_MODF), (float*)(ws + WS_X1)};
        pg8::gemm_phase<pg8::EpiX1, pg8::StaticOrder, true>(F.lds, g, S, E);
    }

    SEAM(7);
    if (IN(8)) { { int* rt = (int*)(ws + WS_ROUTE + RT_TOK); for (int i = F.vcu * (NWAVES * 64) + F.tid; i < PMAX; i += F.G * NWAVES * 64) rt[i] = 0; }
        for (int u = F.vcu; u < NUNIT64; u += F.G) router_unit(F, args, u); }

    SEAM(8);
    if (IN(9)) { for (int u = F.vcu; u < NUNIT64; u += F.G) route_unit(F, args, u); }

    SEAM(9);
    if (IN(10)) {
        const int nmt = __builtin_amdgcn_readfirstlane(*(const int*)(ws + WS_ROUTE + RT_NMT));
        LAS int* tile_lds = (LAS int*)(F.lds + LDSCTL_OFF + 1024);
        if (F.tid < MT_MAX) tile_lds[F.tid] = ((const int*)(ws + WS_ROUTE + RT_TILE))[F.tid < nmt ? F.tid : 0];
        __syncthreads();
        pg8::Gemm g{(const bf16*)(ws + WS_H2F8), (const bf16*)(ws + WS_WGU), D}; pg8::MoeGatherOrder S; S.init(nmt, 16, F.G, (int)blockIdx.x, tile_lds); S.rowtok = (const int*)(ws + WS_ROUTE + RT_TOK);
        pg8::EpiUp E{args.in[I_BGU], (unsigned char*)(ws + WS_ACT)};
        pg8::gemm_phase<pg8::EpiUp, pg8::MoeGatherOrder, true>(F.lds, g, S, E);
    }

    SEAM(10);
    if (IN(11)) {
        const int nmt = __builtin_amdgcn_readfirstlane(*(const int*)(ws + WS_ROUTE + RT_NMT));
        LAS int* tile_lds = (LAS int*)(F.lds + LDSCTL_OFF + 1024);
        if (F.tid < MT_MAX) tile_lds[F.tid] = ((const int*)(ws + WS_ROUTE + RT_TILE))[F.tid < nmt ? F.tid : 0];
        __syncthreads();
        pg8::Gemm g{(const bf16*)(ws + WS_ACT), (const bf16*)(ws + WS_WD), DFF}; pg8::MoeOrder S; S.init(nmt, 8, F.G, (int)blockIdx.x, tile_lds);
        pg8::EpiDown E{args.in[I_BD], (const float*)(ws + WS_ROUTE + RT_GATE), (bf16*)(ws + WS_YS)};
        pg8::gemm_phase<pg8::EpiDown, pg8::MoeOrder, true>(F.lds, g, S, E);
    }

    SEAM(11);
    if (IN(12)) { final_rows<(MK_STAGE >= 9)>(F, args, gw, NGW); }

#undef IN
#undef SEAM
}

extern "C" void kernel_launch(void* const* d_in, const int* in_sizes, int n_in, void* d_out, int out_size, void* d_ws, size_t ws_size, hipStream_t stream) {
    static int grid = 0;
    if (grid == 0) {
        if (n_in != 23 || out_size != T * D || ws_size < WS_END) { fprintf(stderr, "kernel_launch: unexpected shapes (n_in %d, out %d, ws %zu < %zu)\n", n_in, out_size, ws_size, (size_t)WS_END); grid = -1; return; }
        int dev = 0, cus = 0, per_cu = 0;
        if (hipGetDevice(&dev) != hipSuccess || hipDeviceGetAttribute(&cus, hipDeviceAttributeMultiprocessorCount, dev) != hipSuccess) { grid = -1; return; }
        if (hipFuncSetAttribute((const void*)fwd_kernel, hipFuncAttributeMaxDynamicSharedMemorySize, LDS_BYTES) != hipSuccess) { fprintf(stderr, "kernel_launch: hipFuncSetAttribute failed\n"); grid = -1; return; }
        if (hipOccupancyMaxActiveBlocksPerMultiprocessor(&per_cu, (const void*)fwd_kernel, NWAVES * 64, LDS_BYTES) != hipSuccess || per_cu < 1) { fprintf(stderr, "kernel_launch: occupancy query says %d\n", per_cu); }
        (void)hipGetLastError();
        grid = cus;
    }
    if (grid < 0) return;
    (void)hipMemsetAsync((char*)d_ws + WS_CTL, 0, CTL_ZERO_BYTES, stream);
    Args a{};
    for (int i = 0; i < 23; ++i) a.in[i] = (const float*)d_in[i];
    a.out = (float*)d_out; a.ws = (unsigned char*)d_ws;
    if (N_LAUNCHES == 1) { a.ph_lo = 0; a.ph_hi = N_PHASES; hipLaunchKernelGGL(fwd_kernel, dim3(grid), dim3(NWAVES * 64), LDS_BYTES, stream, a); }
    else { for (int p = 0; p < N_PHASES; ++p) {
#if MK_STAGE < 9
        if (p >= 8 && p < 12) continue;
#endif
        a.ph_lo = p; a.ph_hi = p + 1; hipLaunchKernelGGL(fwd_kernel, dim3(grid), dim3(NWAVES * 64), LDS_BYTES, stream, a); } }
}
```

```cpp
#include <hip/hip_runtime.h>
#include <cstdio>
#include <cstdint>

#ifndef MK_N_LAUNCHES
#define MK_N_LAUNCHES 1
#endif
#ifndef MK_STAGE
#define MK_STAGE 9
#endif

#define GAS __attribute__((address_space(1)))
#define LAS __attribute__((address_space(3)))
typedef unsigned short bf16;
typedef short bf16x8 __attribute__((ext_vector_type(8)));
typedef short s16x4 __attribute__((ext_vector_type(4)));
typedef float f32x2 __attribute__((ext_vector_type(2)));
typedef float f32x4 __attribute__((ext_vector_type(4)));
typedef float f32x16 __attribute__((ext_vector_type(16)));
typedef unsigned u32x2 __attribute__((ext_vector_type(2)));
typedef unsigned u32x4 __attribute__((ext_vector_type(4)));
typedef GAS unsigned gu32;
typedef int i32x8 __attribute__((ext_vector_type(8)));
constexpr float W8_SCALE = 32.0f, W8_INV = 1.0f / 32.0f;
__device__ __forceinline__ unsigned cvt4_fp8(float a, float b, float c, float d) { int w = 0; w = __builtin_amdgcn_cvt_pk_fp8_f32(a, b, w, false); w = __builtin_amdgcn_cvt_pk_fp8_f32(c, d, w, true); return (unsigned)w; }
#define RLX_AGENT __ATOMIC_RELAXED, __HIP_MEMORY_SCOPE_AGENT
#define LDS_WAIT() asm volatile("s_waitcnt lgkmcnt(0)" ::: "memory")
#define VM_WAIT() asm volatile("s_waitcnt vmcnt(0)" ::: "memory")
#define LDS_BARRIER() do { asm volatile("s_waitcnt lgkmcnt(0)" ::: "memory"); __builtin_amdgcn_s_barrier(); asm volatile("" ::: "memory"); } while (0)

constexpr int D = 2048, NB = 8, SEQ = 2048, T = NB * SEQ;
constexpr int NIN_SRC = 12688, NIN = 12800;
constexpr int NIN_A = 2304, NIN_B = 10496;
constexpr int NE = 32, TOPK = 4, DFF = 2048;
constexpr int PMAX = T * TOPK + NE * 256;
constexpr int MT_MAX = PMAX / 256;
constexpr int KC = 8;
constexpr float EPS = 1e-6f;
constexpr float IDX_W_SCALE = 0.25f * 0.08838834764831845f;
constexpr int KSEL = 256;

constexpr size_t MiB = 1u << 20;
constexpr size_t WS_CTL = 0, CTL_ZERO_BYTES = 1 * MiB;
constexpr size_t WS_MODP = 1 * MiB;
constexpr size_t WS_MODF = 13 * MiB;
constexpr size_t WS_WKV = 14 * MiB;
constexpr size_t WS_WSP = 16 * MiB;
constexpr size_t WS_WRT = 17 * MiB;
constexpr size_t WS_SSQ = 18 * MiB;
constexpr size_t WS_WI = 19 * MiB;
constexpr size_t WS_KI = 20 * MiB;
constexpr size_t WS_MASK = 24 * MiB;
constexpr size_t WS_ROUTE = 28 * MiB;
constexpr size_t WS_CKV = 30 * MiB;
constexpr size_t WS_WPA = 40 * MiB, WS_WPB = 48 * MiB, WS_WOUT = 56 * MiB;
constexpr size_t WS_WIN = 64 * MiB;
constexpr size_t WS_WIN8 = 96 * MiB;
constexpr size_t WS_H2F8 = 2176 * MiB;
constexpr size_t WS_H1F8 = 2176 * MiB;
constexpr size_t WS_H1 = 128 * MiB;
constexpr size_t WS_Q = 192 * MiB, WS_QI = 256 * MiB, WS_U = 320 * MiB, WS_V = 384 * MiB, WS_GA = 448 * MiB, WS_GB = 512 * MiB;
constexpr size_t WS_KH = 576 * MiB, WS_VH = 640 * MiB, WS_VST = 704 * MiB  , WS_SG = 768 * MiB, WS_OA = 832 * MiB, WS_YB = 896 * MiB, WS_MIX = 960 * MiB;
constexpr size_t WS_H2 = 1024 * MiB, WS_H2LO = 1088 * MiB;
constexpr size_t WS_SC = 1152 * MiB;
constexpr size_t WS_X1 = 1280 * MiB;
constexpr size_t WS_WGU = 1408 * MiB;
constexpr size_t WS_WD = 1920 * MiB;
constexpr size_t WS_XG = 2176 * MiB, WS_ACT = 2464 * MiB, WS_YS = 2752 * MiB;
constexpr size_t WS_END = 3040 * MiB;
constexpr size_t RT_TOPE = 0, RT_TOPG = 256 * 1024, RT_POS = 512 * 1024, RT_HIST = 768 * 1024, RT_TILE = 832 * 1024, RT_NMT = 896 * 1024, RT_GATE = 1024 * 1024, RT_TOK = 1536 * 1024;
constexpr int CW_BAR = 4096;

constexpr int RING_BYTES = 147456;
constexpr int LDSCTL_OFF = RING_BYTES, MISC_OFF = LDSCTL_OFF + 320;
constexpr int LDS_BYTES = 155648;
constexpr int NWAVES = 8;

__device__ __forceinline__ unsigned cvtpk(float lo, float hi) { unsigned r; asm volatile("v_cvt_pk_bf16_f32 %0, %1, %2" : "=v"(r) : "v"(lo), "v"(hi)); return r; }
__device__ __forceinline__ void gload_x4_untracked(f32x4& dst, const float* p) { asm volatile("global_load_dwordx4 %0, %1, off" : "=v"(dst) : "v"(p) : "memory"); }
__device__ __forceinline__ void gload_x1_untracked(float& dst, const float* p) { asm volatile("global_load_dword %0, %1, off" : "=v"(dst) : "v"(p) : "memory"); }
__device__ __forceinline__ float bf2f(unsigned short h) { return __builtin_bit_cast(float, (unsigned)h << 16); }
__device__ __forceinline__ float bflo(unsigned w) { return __builtin_bit_cast(float, w << 16); }
__device__ __forceinline__ float bfhi(unsigned w) { return __builtin_bit_cast(float, w & 0xffff0000u); }
__device__ __forceinline__ float wave_sum(float v) {
#pragma unroll
    for (int o = 1; o < 64; o <<= 1) v += __shfl_xor(v, o);
    return v;
}
__device__ __forceinline__ float sigmoidf_(float x) { return __builtin_amdgcn_rcpf(1.0f + __builtin_amdgcn_exp2f(-1.4426950408889634f * x)); }
__device__ __forceinline__ f32x2 gelu_pk(f32x2 v) {
    const f32x2 av = __builtin_elementwise_abs(v), d = av * 0.2316418882f + 1.0f;
    f32x2 t; t.x = __builtin_amdgcn_rcpf(d.x); t.y = __builtin_amdgcn_rcpf(d.y);
    f32x2 q = t * 0.5307027145f + (-0.7265760135f); q = q * t + 0.7107068705f; q = q * t + (-0.142248368f); q = q * t + 0.127414796f; q = q * t;
    const f32x2 s = (v * v) * (-0.72134752044f);
    f32x2 e; e.x = __builtin_amdgcn_exp2f(s.x); e.y = __builtin_amdgcn_exp2f(s.y);
    const f32x2 m = v * (q * e), r = v - m;
    f32x2 o; o.x = v.x < 0.f ? m.x : r.x; o.y = v.y < 0.f ? m.y : r.y; return o;
}

namespace pg8 {
constexpr int BM = 256, BK = 64, HALF = 128, HTB = HALF * BK * 2, STAGE_BYTES = 8 * HTB, NXCD = 8, WGM = 4;
__host__ __device__ __forceinline__ int lds_byte(int r, int c) { const int st = (r >> 4) * 2 + (c >> 5), rr = r & 15, cc = c & 31, ob = rr * 64 + cc * 2; return st * 1024 + (ob ^ (((ob >> 9) & 1) << 5)); }
__host__ __device__ __forceinline__ void stage_rc(int b, int& R, int& C) { const int st = b / 1024, sb = b % 1024, swz = sb ^ (((sb >> 9) & 1) << 5); R = (st >> 1) * 16 + swz / 64; C = (st & 1) * 32 + (swz % 64) / 2; }
__host__ __device__ __forceinline__ int perm32(int rho) { const int n = rho >> 4, i = rho & 15; return 8 * (i >> 2) + 4 * n + (i & 3); }

struct Unit { int pm, pn, pb, e; };
struct Gemm { const bf16* A; const bf16* Bt; int K; };
template <class S, class = void> struct SchedGather { static constexpr bool v = false; };
template <class S> struct SchedGather<S, decltype((void)S::GATHER)> { static constexpr bool v = S::GATHER; };

struct StaticOrder {
    int nM, nN, nwg, G, c;
    __device__ void init(int M, int N, int G_, int c_) { nM = M / BM; nN = N / BM; nwg = nM * nN; G = G_; c = c_; }
    __device__ bool next(int i, Unit& u) const {
        const long L = (long)i * G + c; if (L >= nwg) return false;
        int wgid = (int)L; { const int q = nwg / NXCD, r = nwg % NXCD, xcd = wgid % NXCD, off = wgid / NXCD; wgid = (xcd < r ? xcd * (q + 1) : r * (q + 1) + (xcd - r) * q) + off; }
        const int nig = WGM * nN, gid = wgid / nig, fm = gid * WGM, gsz = (nM - fm) < WGM ? (nM - fm) : WGM;
        u.pm = fm + ((wgid % nig) % gsz); u.pn = (wgid % nig) / gsz; u.pb = u.pn; u.e = 0; return true;
    }
};
struct UnevenOrder {
    static constexpr int FR = 9, XR = 2, C0 = 64;
    StaticOrder so; bool uneven;
    __device__ void init(int M, int N, int G_, int c_) { so.init(M, N, G_, c_); uneven = (G_ == 256 && so.nwg % NXCD == 0 && so.nwg >= FR * 256 && so.nwg <= FR * 256 + XR * (256 - C0)); }
    __device__ bool next(int i, Unit& u) const {
        if (!uneven) return so.next(i, u);
        long L;
        if (i < FR) L = (long)i * 256 + so.c; else { if (so.c < C0 || i >= FR + XR) return false; L = FR * 256 + (long)(i - FR) * (256 - C0) + (so.c - C0); if (L >= so.nwg) return false; }
        int wgid = (int)L; { const int q = so.nwg / NXCD, xcd = wgid % NXCD, off = wgid / NXCD; wgid = xcd * q + off; }
        const int nig = WGM * so.nN, gid = wgid / nig, fm = gid * WGM, gsz = (so.nM - fm) < WGM ? (so.nM - fm) : WGM;
        u.pm = fm + ((wgid % nig) % gsz); u.pn = (wgid % nig) / gsz; u.pb = u.pn; u.e = 0; return true;
    }
};
struct MoeOrder {
    int nM, nN, nwg, G, c; const LAS int* tile_e;
    __device__ void init(int nM_, int nN_, int G_, int c_, const LAS int* te) { nM = nM_; nN = nN_; nwg = nM * nN; G = G_; c = c_; tile_e = te; }
    __device__ bool next(int i, Unit& u) const {
        const long L = (long)i * G + c; if (L >= nwg) return false;
        int wgid = (int)L; { const int q = nwg / NXCD, r = nwg % NXCD, xcd = wgid % NXCD, off = wgid / NXCD; wgid = (xcd < r ? xcd * (q + 1) : r * (q + 1) + (xcd - r) * q) + off; }
        const int nig = WGM * nN, gid = wgid / nig, fm = gid * WGM, gsz = (nM - fm) < WGM ? (nM - fm) : WGM;
        u.pm = fm + ((wgid % nig) % gsz); u.pn = (wgid % nig) / gsz; u.e = __builtin_amdgcn_readfirstlane(tile_e[u.pm]); u.pb = u.e * nN + u.pn; return true;
    }
};

struct MoeGatherOrder : MoeOrder { static constexpr bool GATHER = true; const int* rowtok; };
template <class Epi, class Sched, bool F8 = false, bool ALIGN_EPI = true>
__device__ __forceinline__ void gemm_phase(LAS unsigned char* lds, const Gemm g, const Sched& S, const Epi& E) {
    const int tid = threadIdx.x, wid = __builtin_amdgcn_readfirstlane(tid >> 6), lane = tid & 63, wr = wid >> 2, wc = wid & 3, fr = lane & 15, fq = lane >> 4;
    const int K = F8 ? g.K / 2 : g.K, nt = K / BK;
    constexpr bool GA = SchedGather<Sched>::v;
    unsigned voffA[2], voffB[2]; int Rr[2]; unsigned cofs[2];
#pragma unroll
    for (int i = 0; i < 2; ++i) { int R, C; stage_rc(tid * 16 + i * 8192, R, C); const int Rb = Epi::PERM ? ((R & ~31) + perm32(R & 31)) : R;
        voffA[i] = (unsigned)(R * K + C) * 2u; voffB[i] = (unsigned)(Rb * K + C) * 2u; Rr[i] = R; cofs[i] = (unsigned)C * 2u; }
    unsigned gC[2][2], gN[2][2]; int tokN[2][2];
    const size_t kstep = (size_t)(BK * 2);
    const size_t hstep = (size_t)HALF * K * 2;
    const size_t tstep = 2 * hstep;
    const unsigned ldsw = (unsigned)wid * 1024u;
    const int aoff = lds_byte(wr * 64 + fr, fq * 8), boff = lds_byte(wc * 32 + fr, fq * 8);
#define PG8_SA(b, h) (((b) * 2 + (h)) * HTB)
#define PG8_SB(b, h) ((4 + (b) * 2 + (h)) * HTB)
#define PG8_STAGE(bufoff, gbase, voff) do { _Pragma("unroll") for (int _i = 0; _i < 2; ++_i) \
        __builtin_amdgcn_global_load_lds((const unsigned*)((const char*)(gbase) + (voff)[_i]), (LAS unsigned*)(lds + (bufoff) + ldsw + _i * 8192), 16, 0, 0); } while (0)
#define PG8_STAGE_A(bufoff, kb, h, NX) do { if constexpr (GA) { _Pragma("unroll") for (int _i = 0; _i < 2; ++_i) { const unsigned vo_ = (NX) ? gN[h][_i] : gC[h][_i]; \
        __builtin_amdgcn_global_load_lds((const unsigned*)((const char*)(kb) + vo_), (LAS unsigned*)(lds + (bufoff) + ldsw + _i * 8192), 16, 0, 0); } } else PG8_STAGE(bufoff, (kb) + ((h) ? hstep : 0), voffA); } while (0)
#define PG8_LD8(p_) ({ const u32x4 lo_ = *(const LAS u32x4*)(p_), hi_ = *(const LAS u32x4*)((p_) + 1024); (i32x8){(int)lo_.x, (int)lo_.y, (int)lo_.z, (int)lo_.w, (int)hi_.x, (int)hi_.y, (int)hi_.z, (int)hi_.w}; })
#define PG8_LDA(dst, b, h) do { if constexpr (F8) { _Pragma("unroll") for (int m = 0; m < 4; ++m) dst##8[m] = PG8_LD8(lds + PG8_SA(b, h) + aoff + m * 2048); } else { \
        _Pragma("unroll") for (int m = 0; m < 4; ++m) _Pragma("unroll") for (int k = 0; k < 2; ++k) dst[m][k] = *(const LAS bf16x8*)(lds + PG8_SA(b, h) + aoff + m * 2048 + k * 1024); } } while (0)
#define PG8_LDB(dst, b, h) do { if constexpr (F8) { _Pragma("unroll") for (int n = 0; n < 2; ++n) dst##8[n] = PG8_LD8(lds + PG8_SB(b, h) + boff + n * 2048); } else { \
        _Pragma("unroll") for (int n = 0; n < 2; ++n) _Pragma("unroll") for (int k = 0; k < 2; ++k) dst[n][k] = *(const LAS bf16x8*)(lds + PG8_SB(b, h) + boff + n * 2048 + k * 1024); } } while (0)
#define PG8_MMA(ai, bj, At, Bt) do { __builtin_amdgcn_s_setprio(1); if constexpr (F8) { _Pragma("unroll") for (int m = 0; m < 4; ++m) _Pragma("unroll") for (int n = 0; n < 2; ++n) \
        asm volatile("v_mfma_f32_16x16x128_f8f6f4 %0, %1, %2, %0" : "+v"(acc[ai][bj][m][n]) : "v"(Bt##8[n]), "v"(At##8[m])); } else { \
        _Pragma("unroll") for (int m = 0; m < 4; ++m) _Pragma("unroll") for (int n = 0; n < 2; ++n) _Pragma("unroll") for (int k = 0; k < 2; ++k) \
        acc[ai][bj][m][n] = __builtin_amdgcn_mfma_f32_16x16x32_bf16(Bt[n][k], At[m][k], acc[ai][bj][m][n], 0, 0, 0); } __builtin_amdgcn_s_setprio(0); } while (0)
#define PG8_WAIT_V(n) asm volatile("s_waitcnt vmcnt(" #n ")" ::: "memory")
#define PG8_WAIT_V8L() do { if (Epi::HAS_PRE && last) asm volatile("s_waitcnt vmcnt(%0)" :: "i"(8 + Epi::NPRE) : "memory"); else asm volatile("s_waitcnt vmcnt(8)" ::: "memory"); } while (0)
#define PG8_WAIT_L(n) asm volatile("s_waitcnt lgkmcnt(" #n ")" ::: "memory")
#define PG8_BAR __builtin_amdgcn_s_barrier()
#define PG8_SCHED __builtin_amdgcn_sched_barrier(0)
    Unit cur, nxt; int ui = 0;
    if (!S.next(0, cur)) return;
    f32x4 acc[2][2][4][2];
#pragma unroll
    for (int a = 0; a < 2; ++a)
#pragma unroll
        for (int b = 0; b < 2; ++b)
#pragma unroll
            for (int m = 0; m < 4; ++m)
#pragma unroll
                for (int n = 0; n < 2; ++n) acc[a][b][m][n] = (f32x4){0.f, 0.f, 0.f, 0.f};
    typename Epi::Pre epre;
    bf16x8 At[4][2], B0[2][2], B1[2][2]; i32x8 At8[4], B08[2], B18[2];
    const char* cA = GA ? (const char*)g.A : (const char*)g.A + (size_t)cur.pm * tstep; const char* cB = (const char*)g.Bt + (size_t)cur.pb * tstep;
    if constexpr (GA) {
#pragma unroll
        for (int h = 0; h < 2; ++h)
#pragma unroll
            for (int i = 0; i < 2; ++i) { gC[h][i] = (unsigned)S.rowtok[cur.pm * BM + h * HALF + Rr[i]] * (unsigned)(K * 2) + cofs[i]; gN[h][i] = gC[h][i]; tokN[h][i] = 0; } }
    PG8_STAGE(PG8_SB(0, 0), cB, voffB); PG8_STAGE(PG8_SB(0, 1), cB + hstep, voffB); PG8_STAGE_A(PG8_SA(0, 0), cA, 0, false); PG8_STAGE_A(PG8_SA(0, 1), cA, 1, false);
    if (wr == 1) PG8_BAR;
    PG8_WAIT_V(2); PG8_BAR;
    PG8_STAGE(PG8_SB(1, 0), cB + kstep, voffB); PG8_STAGE_A(PG8_SA(1, 0), cA + kstep, 0, false); PG8_STAGE(PG8_SB(1, 1), cB + hstep + kstep, voffB);
    PG8_WAIT_V(6); PG8_BAR;
    for (;;) {
        const bool has_next = S.next(ui + 1, nxt);
        const char* nA = GA ? cA : (has_next ? (const char*)g.A + (size_t)nxt.pm * tstep : cA); const char* nB = has_next ? (const char*)g.Bt + (size_t)nxt.pb * tstep : cB;
        if constexpr (GA) { if (has_next) {
#pragma unroll
            for (int h = 0; h < 2; ++h)
#pragma unroll
                for (int i = 0; i < 2; ++i) asm volatile("global_load_dword %0, %1, off" : "=v"(tokN[h][i]) : "v"(S.rowtok + nxt.pm * BM + h * HALF + Rr[i]) : "memory"); } }
        for (int t = 0; t < nt; t += 2) {
            const bool last = (t == nt - 2);
            if constexpr (GA) { if (last && has_next) {
#pragma unroll
                for (int h = 0; h < 2; ++h)
#pragma unroll
                    for (int i = 0; i < 2; ++i) { asm volatile("" : "+v"(tokN[h][i])); gN[h][i] = (unsigned)tokN[h][i] * (unsigned)(K * 2) + cofs[i]; } } }
            if constexpr (Epi::HAS_PRE) { if (last) { int lp_; asm volatile("v_mbcnt_lo_u32_b32 %0, -1, 0\n\tv_mbcnt_hi_u32_b32 %0, -1, %0" : "=v"(lp_)); E.pre(epre, cur, wr, wc, lp_ & 15, lp_ >> 4); } }
            const char* a1 = cA + (size_t)(t + 1) * kstep;
            const char* a2 = last ? nA : cA + (size_t)(t + 2) * kstep; const char* b2 = last ? nB : cB + (size_t)(t + 2) * kstep;
            const char* a3 = a2 + kstep; const char* b3 = b2 + kstep;
            PG8_LDB(B0, 0, 0); PG8_LDB(B1, 0, 1); PG8_SCHED; PG8_LDA(At, 0, 0); PG8_STAGE_A(PG8_SA(1, 1), a1, 1, false);
            PG8_WAIT_V8L(); PG8_WAIT_L(0); PG8_BAR; PG8_MMA(0, 0, At, B0); PG8_MMA(0, 1, At, B1); PG8_BAR; PG8_SCHED;
            PG8_LDA(At, 0, 1); PG8_STAGE(PG8_SB(0, 0), b2, voffB); PG8_STAGE(PG8_SB(0, 1), b2 + hstep, voffB); PG8_STAGE_A(PG8_SA(0, 0), a2, 0, last);
            PG8_WAIT_V8L(); PG8_WAIT_L(0); PG8_BAR; PG8_MMA(1, 0, At, B0); PG8_MMA(1, 1, At, B1); PG8_BAR; PG8_SCHED;
            PG8_LDB(B0, 1, 0); PG8_LDB(B1, 1, 1); PG8_SCHED; PG8_LDA(At, 1, 0); PG8_STAGE_A(PG8_SA(0, 1), a2, 1, last);
            PG8_WAIT_V(8); PG8_WAIT_L(0); PG8_BAR; PG8_MMA(0, 0, At, B0); PG8_MMA(0, 1, At, B1); PG8_BAR; PG8_SCHED;
            PG8_LDA(At, 1, 1); PG8_STAGE(PG8_SB(1, 0), b3, voffB); PG8_STAGE(PG8_SB(1, 1), b3 + hstep, voffB); PG8_STAGE_A(PG8_SA(1, 0), a3, 0, last);
            PG8_WAIT_V(8); PG8_WAIT_L(0); PG8_BAR; PG8_MMA(1, 0, At, B0); PG8_MMA(1, 1, At, B1); PG8_BAR; PG8_SCHED;
        }
        if constexpr (F8) asm volatile("s_nop 15\n\ts_nop 15" ::: "memory");
        if constexpr (ALIGN_EPI) { if (wr == 0) PG8_BAR; }
        { int ln_; asm volatile("v_mbcnt_lo_u32_b32 %0, -1, 0\n\tv_mbcnt_hi_u32_b32 %0, -1, %0" : "=v"(ln_));
          if constexpr (Epi::HAS_PRE) E(acc, cur, wr, wc, ln_ & 15, ln_ >> 4, epre); else E(acc, cur, wr, wc, ln_ & 15, ln_ >> 4); }
        if (!has_next) break;
#pragma unroll
        for (int a = 0; a < 2; ++a)
#pragma unroll
            for (int b = 0; b < 2; ++b)
#pragma unroll
                for (int m = 0; m < 4; ++m)
#pragma unroll
                    for (int n = 0; n < 2; ++n) acc[a][b][m][n] = (f32x4){0.f, 0.f, 0.f, 0.f};
        cur = nxt; cA = nA; cB = nB; ++ui;
        if constexpr (GA) {
#pragma unroll
            for (int h = 0; h < 2; ++h)
#pragma unroll
                for (int i = 0; i < 2; ++i) gC[h][i] = gN[h][i]; }
        if constexpr (ALIGN_EPI) { if (wr == 1) PG8_BAR; }
    }
    PG8_WAIT_V(0);
    if constexpr (!ALIGN_EPI) { if (wr == 0) PG8_BAR; }
    PG8_BAR;
#undef PG8_SA
#undef PG8_SB
#undef PG8_STAGE
#undef PG8_STAGE_A
#undef PG8_LDA
#undef PG8_LD8
#undef PG8_LDB
#undef PG8_MMA
#undef PG8_WAIT_V
#undef PG8_WAIT_V8L
#undef PG8_WAIT_L
#undef PG8_BAR
#undef PG8_SCHED
}

typedef f32x4 Acc[2][2][4][2];
__device__ __forceinline__ u32x4 pack8(const f32x4 a, const f32x4 b) { u32x4 w; w.x = cvtpk(a[0], a[1]); w.y = cvtpk(a[2], a[3]); w.z = cvtpk(b[0], b[1]); w.w = cvtpk(b[2], b[3]); return w; }
__device__ __forceinline__ void unpack8(const u32x4 w, f32x4& a, f32x4& b) { a = (f32x4){bflo(w.x), bfhi(w.x), bflo(w.y), bfhi(w.y)}; b = (f32x4){bflo(w.z), bfhi(w.z), bflo(w.w), bfhi(w.w)}; }

struct EpiG1 {
    static constexpr bool PERM = true; static constexpr bool HAS_PRE = false; static constexpr int NPRE = 0; struct Pre {};
    bf16 *QI, *KI; float* WI;
    __device__ __forceinline__ void operator()(const Acc& acc, const Unit& u, int wr, int wc, int fr, int fq) const {
        const int pn = u.pn, row0 = u.pm * BM + wr * 64 + fr, cw = wc * 32 + 8 * fq;
        if (pn == 8) {
#pragma unroll
            for (int ai = 0; ai < 2; ++ai)
#pragma unroll
                for (int m = 0; m < 4; ++m) { const int row = row0 + ai * HALF + m * 16;
                    *(u32x4*)(KI + (size_t)row * 128 + cw) = pack8(acc[ai][0][m][0] * W8_INV, acc[ai][0][m][1] * W8_INV);
                    if (wc == 0 && fq < 2) { float* wp = WI + (size_t)row * 16 + 8 * fq; *(f32x4*)wp = acc[ai][1][m][0] * (IDX_W_SCALE * W8_INV); *(f32x4*)(wp + 4) = acc[ai][1][m][1] * (IDX_W_SCALE * W8_INV); } }
        } else {
#pragma unroll
            for (int ai = 0; ai < 2; ++ai)
#pragma unroll
                for (int m = 0; m < 4; ++m) { bf16* rowp = QI + (size_t)(row0 + ai * HALF + m * 16) * D + pn * 256 + cw;
#pragma unroll
                    for (int bj = 0; bj < 2; ++bj) *(u32x4*)(rowp + bj * HALF) = pack8(acc[ai][bj][m][0] * W8_INV, acc[ai][bj][m][1] * W8_INV); }
        }
    }
};
struct EpiG1b {
    static constexpr bool PERM = true; static constexpr bool HAS_PRE = false; static constexpr int NPRE = 0; struct Pre {};
    unsigned char* ws;
    __device__ __forceinline__ void operator()(const Acc& acc, const Unit& u, int wr, int wc, int fr, int fq) const {
        const int pn = u.pn, row0 = u.pm * BM + wr * 64 + fr, cw = wc * 32 + 8 * fq;
        bf16* const Q = (bf16*)(ws + WS_Q); bf16* const CKV = (bf16*)(ws + WS_CKV); float* const SSQ = (float*)(ws + WS_SSQ); float* const VST = (float*)(ws + WS_VST);
        if (pn == 8) {
#pragma unroll
            for (int ai = 0; ai < 2; ++ai)
#pragma unroll
                for (int m = 0; m < 4; ++m) { const int row = row0 + ai * HALF + m * 16; bf16* rowp = CKV + (size_t)row * 256 + cw; float sq = 0.f;
#pragma unroll
                    for (int bj = 0; bj < 2; ++bj) { const f32x4 v0 = acc[ai][bj][m][0] * W8_INV, v1 = acc[ai][bj][m][1] * W8_INV;
                        sq += (v0[0] * v0[0] + v0[1] * v0[1]) + (v0[2] * v0[2] + v0[3] * v0[3]) + (v1[0] * v1[0] + v1[1] * v1[1]) + (v1[2] * v1[2] + v1[3] * v1[3]);
                        *(u32x4*)(rowp + bj * HALF) = pack8(v0, v1); }
                    sq += __shfl_xor(sq, 16); sq += __shfl_xor(sq, 32);
                    if (fq == 0) SSQ[(size_t)row * 4 + wc] = sq; }
            return; }
        if (pn < 8) {
#pragma unroll
            for (int ai = 0; ai < 2; ++ai)
#pragma unroll
                for (int m = 0; m < 4; ++m) { bf16* rowp = Q + (size_t)(row0 + ai * HALF + m * 16) * D + pn * 256 + cw;
#pragma unroll
                    for (int bj = 0; bj < 2; ++bj) *(u32x4*)(rowp + bj * HALF) = pack8(acc[ai][bj][m][0] * W8_INV, acc[ai][bj][m][1] * W8_INV); }
            return; }
        const int pz = pn - 9;
        bf16* O = (bf16*)(ws + (pz < 8 ? WS_U : (pz < 16 ? WS_V : (pz < 24 ? WS_GA : WS_GB)))); const int colt = pz & 7; const bool gl = pz < 16, st = (pz >> 3) == 1;
#pragma unroll
        for (int ai = 0; ai < 2; ++ai)
#pragma unroll
            for (int m = 0; m < 4; ++m) { const int row = row0 + ai * HALF + m * 16; bf16* rowp = O + (size_t)row * D + colt * 256 + cw; float s1 = 0.f, s2 = 0.f;
#pragma unroll
                for (int bj = 0; bj < 2; ++bj) { f32x4 v0 = acc[ai][bj][m][0] * W8_INV, v1 = acc[ai][bj][m][1] * W8_INV;
                    if (gl) { const f32x2 a = gelu_pk((f32x2){v0[0], v0[1]}), b = gelu_pk((f32x2){v0[2], v0[3]}), c = gelu_pk((f32x2){v1[0], v1[1]}), d = gelu_pk((f32x2){v1[2], v1[3]});
                        v0 = (f32x4){a.x, a.y, b.x, b.y}; v1 = (f32x4){c.x, c.y, d.x, d.y};
                        s1 += (v0[0] + v0[1]) + (v0[2] + v0[3]) + (v1[0] + v1[1]) + (v1[2] + v1[3]);
                        s2 += (v0[0] * v0[0] + v0[1] * v0[1]) + (v0[2] * v0[2] + v0[3] * v0[3]) + (v1[0] * v1[0] + v1[1] * v1[1]) + (v1[2] * v1[2] + v1[3] * v1[3]); }
                    else {
#pragma unroll
                        for (int e = 0; e < 4; ++e) { v0[e] = sigmoidf_(v0[e]); v1[e] = sigmoidf_(v1[e]); } }
                    *(u32x4*)(rowp + bj * HALF) = pack8(v0, v1); }
                if (st) { s1 += __shfl_xor(s1, 16); s1 += __shfl_xor(s1, 32); s2 += __shfl_xor(s2, 16); s2 += __shfl_xor(s2, 32);
                    if (fq == 0) *(f32x2*)(VST + ((size_t)row * 32 + colt * 4 + wc) * 2) = (f32x2){s1, s2}; } }
    }
};
struct EpiKV {
    static constexpr bool PERM = true; static constexpr bool HAS_PRE = false; static constexpr int NPRE = 0; struct Pre {};
    bf16 *KH, *VH; const float* SSQ;
    __device__ __forceinline__ void operator()(const Acc& acc, const Unit& u, int wr, int wc, int fr, int fq) const {
        const int row0 = u.pm * BM + wr * 64 + fr, cw = wc * 32 + 8 * fq;
        bf16* O = u.pn < 8 ? KH : VH; const int colt = (u.pn & 7) * 256;
        f32x4 sq[2][4];
#pragma unroll
        for (int ai = 0; ai < 2; ++ai)
#pragma unroll
            for (int m = 0; m < 4; ++m) sq[ai][m] = *(const f32x4*)(SSQ + (size_t)(row0 + ai * HALF + m * 16) * 4);
#pragma unroll
        for (int ai = 0; ai < 2; ++ai)
#pragma unroll
            for (int m = 0; m < 4; ++m) { const int row = row0 + ai * HALF + m * 16; const f32x4 q = sq[ai][m];
                const float rstd = 1.0f / sqrtf(((q[0] + q[1]) + (q[2] + q[3])) * (1.0f / 256.0f) + EPS);
                bf16* rowp = O + (size_t)row * D + colt + cw;
#pragma unroll
                for (int bj = 0; bj < 2; ++bj) *(u32x4*)(rowp + bj * HALF) = pack8(acc[ai][bj][m][0] * rstd, acc[ai][bj][m][1] * rstd); }
    }
};
template <bool ADD> struct EpiGate {
    static constexpr bool PERM = true; static constexpr bool HAS_PRE = false; static constexpr int NPRE = 0; struct Pre {};
    const bf16* G; const bf16* Y; void* O;
    __device__ __forceinline__ void operator()(const Acc& acc, const Unit& u, int wr, int wc, int fr, int fq) const {
        const int row0 = u.pm * BM + wr * 64 + fr, col0 = u.pn * BM + wc * 32 + 8 * fq;
#pragma unroll
        for (int ai = 0; ai < 2; ++ai) {
            u32x4 gv[4][2], yv[4][2];
#pragma unroll
            for (int m = 0; m < 4; ++m)
#pragma unroll
                for (int bj = 0; bj < 2; ++bj) { const size_t off = (size_t)(row0 + ai * HALF + m * 16) * D + col0 + bj * HALF; gv[m][bj] = *(const u32x4*)(G + off); if (ADD) yv[m][bj] = *(const u32x4*)(Y + off); }
#pragma unroll
            for (int m = 0; m < 4; ++m)
#pragma unroll
                for (int bj = 0; bj < 2; ++bj) { const size_t off = (size_t)(row0 + ai * HALF + m * 16) * D + col0 + bj * HALF; f32x4 g0, g1; unpack8(gv[m][bj], g0, g1);
                    f32x4 v0 = acc[ai][bj][m][0] * W8_INV * g0, v1 = acc[ai][bj][m][1] * W8_INV * g1;
                    if (ADD) { f32x4 y0, y1; unpack8(yv[m][bj], y0, y1); v0 += y0; v1 += y1;
                        u32x2 w; w.x = cvt4_fp8(v0[0], v0[1], v0[2], v0[3]); w.y = cvt4_fp8(v1[0], v1[1], v1[2], v1[3]); *(u32x2*)((unsigned char*)O + off) = w; }
                    else *(u32x4*)((bf16*)O + off) = pack8(v0, v1); } }
    }
};
struct EpiX1 {
    static constexpr bool PERM = false; static constexpr bool HAS_PRE = false; static constexpr int NPRE = 0; struct Pre {};
    const float* X; const float* MODF; float* X1;
    __device__ __forceinline__ void operator()(const Acc& acc, const Unit& u, int wr, int wc, int fr, int fq) const {
        const int row0 = u.pm * BM + wr * 64 + fr, col0 = u.pn * BM + wc * 32 + 4 * fq;
        const float* g1 = MODF + (size_t)(u.pm >> 3) * (6 * D) + 2 * D;
        f32x4 gv[2][2];
#pragma unroll
        for (int bj = 0; bj < 2; ++bj)
#pragma unroll
            for (int n = 0; n < 2; ++n) gv[bj][n] = *(const f32x4*)(g1 + col0 + bj * HALF + n * 16);
#pragma unroll
        for (int ai = 0; ai < 2; ++ai) {
            f32x4 xv[4][2][2];
#pragma unroll
            for (int m = 0; m < 4; ++m)
#pragma unroll
                for (int bj = 0; bj < 2; ++bj)
#pragma unroll
                    for (int n = 0; n < 2; ++n) xv[m][bj][n] = *(const f32x4*)(X + (size_t)(row0 + ai * HALF + m * 16) * D + col0 + bj * HALF + n * 16);
#pragma unroll
            for (int m = 0; m < 4; ++m)
#pragma unroll
                for (int bj = 0; bj < 2; ++bj)
#pragma unroll
                    for (int n = 0; n < 2; ++n) *(f32x4*)(X1 + (size_t)(row0 + ai * HALF + m * 16) * D + col0 + bj * HALF + n * 16) = xv[m][bj][n] + gv[bj][n] * (acc[ai][bj][m][n] * W8_INV); }
    }
};
struct EpiUp {
    static constexpr bool PERM = true, HAS_PRE = true; static constexpr int NPRE = 4;
    struct Pre { f32x4 bg0, bg1, bl0, bl1; };
    const float* BGU; unsigned char* ACT;
    __device__ __forceinline__ void pre(Pre& p, const Unit& u, int wr, int wc, int fr, int fq) const {
        const float* bg = BGU + (size_t)u.e * (2 * DFF) + u.pn * 128 + wc * 32 + 8 * fq;
        gload_x4_untracked(p.bg0, bg); gload_x4_untracked(p.bg1, bg + 4); gload_x4_untracked(p.bl0, bg + DFF); gload_x4_untracked(p.bl1, bg + DFF + 4);
    }
    __device__ __forceinline__ void operator()(const Acc& acc, const Unit& u, int wr, int wc, int fr, int fq, const Pre& p) const {
        const int row0 = u.pm * BM + wr * 64 + fr, j0 = u.pn * 128 + wc * 32 + 8 * fq;
        const f32x4 bg0 = p.bg0, bg1 = p.bg1, bl0 = p.bl0, bl1 = p.bl1;
#pragma unroll
        for (int ai = 0; ai < 2; ++ai)
#pragma unroll
            for (int m = 0; m < 4; ++m) { f32x4 o[2];
#pragma unroll
                for (int n = 0; n < 2; ++n) { const f32x4 hg = acc[ai][0][m][n] * W8_INV + (n ? bg1 : bg0), hl = acc[ai][1][m][n] * W8_INV + (n ? bl1 : bl0);
#pragma unroll
                    for (int e = 0; e < 4; ++e) { const float gg = fminf(hg[e], 7.0f), ll = fminf(fmaxf(hl[e], -7.0f), 7.0f); o[n][e] = gg * sigmoidf_(1.702f * gg) * (ll + 1.0f); } }
                u32x2 w; w.x = cvt4_fp8(o[0][0], o[0][1], o[0][2], o[0][3]); w.y = cvt4_fp8(o[1][0], o[1][1], o[1][2], o[1][3]);
                *(u32x2*)(ACT + (size_t)(row0 + ai * HALF + m * 16) * DFF + j0) = w; }
    }
};
struct EpiDown {
    static constexpr bool PERM = true, HAS_PRE = true; static constexpr int NPRE = 12;
    struct Pre { f32x4 bv[2][2]; float gts[2][4]; };
    const float* BD; const float* RG; bf16* YS;
    __device__ __forceinline__ void pre(Pre& p, const Unit& u, int wr, int wc, int fr, int fq) const {
        const float* bd = BD + (size_t)u.e * D + u.pn * BM + wc * 32 + 8 * fq; const int row0 = u.pm * BM + wr * 64 + fr;
#pragma unroll
        for (int bj = 0; bj < 2; ++bj) { gload_x4_untracked(p.bv[bj][0], bd + bj * HALF); gload_x4_untracked(p.bv[bj][1], bd + bj * HALF + 4); }
#pragma unroll
        for (int ai = 0; ai < 2; ++ai)
#pragma unroll
            for (int m = 0; m < 4; ++m) gload_x1_untracked(p.gts[ai][m], RG + row0 + ai * HALF + m * 16);
    }
    __device__ __forceinline__ void operator()(const Acc& acc, const Unit& u, int wr, int wc, int fr, int fq, const Pre& p) const {
        const int row0 = u.pm * BM + wr * 64 + fr, col0 = u.pn * BM + wc * 32 + 8 * fq;
#pragma unroll
        for (int ai = 0; ai < 2; ++ai)
#pragma unroll
            for (int m = 0; m < 4; ++m) { const int row = row0 + ai * HALF + m * 16; const float gt = p.gts[ai][m]; bf16* rowp = YS + (size_t)row * D + col0;
#pragma unroll
                for (int bj = 0; bj < 2; ++bj) *(u32x4*)(rowp + bj * HALF) = pack8((acc[ai][bj][m][0] * W8_INV + p.bv[bj][0]) * gt, (acc[ai][bj][m][1] * W8_INV + p.bv[bj][1]) * gt); }
    }
};
}

namespace att {
constexpr int DH = 128, PITCH = 2048, NW = 8, QBLK = 32, KVBLK = 64, QB = NW * QBLK;
constexpr int SHM_V = KVBLK * DH * 2, SHM_K = KVBLK * DH * 2;
constexpr int ATT_KV_BYTES = 2 * SHM_V + 2 * SHM_K + NW * 64 * 4;
constexpr int MWAVE = 8192;
constexpr int ATT_LDS_BYTES = ATT_KV_BYTES + NW * MWAVE;
constexpr float SCALE = 0.08838834764831845f, THR = 8.f;
#define KSWZ(row, colB) ((row) * 256 + ((colB) ^ (((row) & 7) << 4)))
#define SBAR() __builtin_amdgcn_sched_barrier(0)
__device__ __forceinline__ int v_st(int k, int c) { const int kk = (k & ~0xC) | ((k & 4) << 1) | ((k & 8) >> 1); return ((kk >> 3) * 4 + (c >> 5)) * 512 + ((kk & 7) * 32 + (c & 31)) * 2; }
__device__ __forceinline__ int v_rd_base(int lane) { return ((lane & 3) << 3) | (((lane >> 2) & 3) << 6) | (((lane >> 4) & 1) << 5) | (((lane >> 5) & 1) << 8); }
constexpr int v_rd_off(int d0, int ks, int half) { return d0 * 512 + ks * 4096 + half * 2048; }
__device__ __forceinline__ int crow(int r, int hi) { return (r & 3) + 8 * (r >> 2) + 4 * hi; }
__device__ __forceinline__ bf16x8 load8(const bf16* p) { return *reinterpret_cast<const bf16x8*>(p); }
__device__ __forceinline__ void mask_bits(f32x16& p0, f32x16& p1, unsigned w0, unsigned w1, int hi) {
    const unsigned a0 = w0 >> (4 * hi), a1 = w1 >> (4 * hi);
    const unsigned NEGB = 0xff800000u;
#pragma unroll
    for (int r = 0; r < 16; ++r) {
        const int c = (r & 3) + 8 * (r >> 2);
        const unsigned m0 = (unsigned)__builtin_amdgcn_sbfe((int)a0, c, 1), m1 = (unsigned)__builtin_amdgcn_sbfe((int)a1, c, 1);
        p0[r] = __uint_as_float((__float_as_uint(p0[r]) & m0) | (NEGB & ~m0));
        p1[r] = __uint_as_float((__float_as_uint(p1[r]) & m1) | (NEGB & ~m1));
    }
}
__device__ __forceinline__ void partialSM(f32x16& p0, f32x16& p1, float& m_reg, float& mn, float& alpha) {
    float pmax = p0[0];
#pragma unroll
    for (int r = 1; r < 16; ++r) pmax = fmaxf(pmax, p0[r]);
#pragma unroll
    for (int r = 0; r < 16; ++r) pmax = fmaxf(pmax, p1[r]);
    { auto rr = __builtin_amdgcn_permlane32_swap(__float_as_uint(pmax), __float_as_uint(pmax), false, false);
      pmax = fmaxf(__uint_as_float(rr[0]), __uint_as_float(rr[1])); }
    constexpr float C2 = 1.4426950408889634f * SCALE;
    if (__builtin_expect(__all((pmax - m_reg) * SCALE <= THR), 1)) { mn = m_reg; alpha = 1.f; }
    else { mn = fmaxf(m_reg, pmax); alpha = __builtin_amdgcn_exp2f((m_reg - mn) * C2); m_reg = mn; }
    const float mnL = -mn * C2;
#pragma unroll
    for (int r = 0; r < 16; ++r) p0[r] = fmaf(p0[r], C2, mnL);
#pragma unroll
    for (int r = 0; r < 16; ++r) p1[r] = fmaf(p1[r], C2, mnL);
#pragma unroll
    for (int r = 0; r < 16; ++r) p0[r] = __builtin_amdgcn_exp2f(p0[r]);
}
__device__ __forceinline__ void finishSM(f32x16& p0, f32x16& p1, float alpha, float& l_reg, bf16x8& pa0, bf16x8& pa1, bf16x8& pa2, bf16x8& pa3) {
#pragma unroll
    for (int r = 0; r < 16; ++r) p1[r] = __builtin_amdgcn_exp2f(p1[r]);
    float ps = 0;
#pragma unroll
    for (int r = 0; r < 16; ++r) ps += p0[r];
#pragma unroll
    for (int r = 0; r < 16; ++r) ps += p1[r];
    { auto rr = __builtin_amdgcn_permlane32_swap(__float_as_uint(ps), __float_as_uint(ps), false, false);
      ps = __uint_as_float(rr[0]) + __uint_as_float(rr[1]); }
    l_reg = l_reg * alpha + ps;
#define PK4(P, B_, OUT) do { unsigned a0 = cvtpk(P[B_+0], P[B_+1]), a1 = cvtpk(P[B_+2], P[B_+3]);                          \
        unsigned b0 = cvtpk(P[B_+4], P[B_+5]), b1 = cvtpk(P[B_+6], P[B_+7]);                                             \
        auto r0 = __builtin_amdgcn_permlane32_swap(a0, b0, false, false); auto r1 = __builtin_amdgcn_permlane32_swap(a1, b1, false, false); \
        u32x4 w = {r0[0], r1[0], r0[1], r1[1]}; OUT = *reinterpret_cast<bf16x8*>(&w); } while (0)
    PK4(p0, 0, pa0); PK4(p0, 8, pa1); PK4(p1, 0, pa2); PK4(p1, 8, pa3);
#undef PK4
}
template <int KB>
__device__ __forceinline__ void qkt(f32x16& p0, f32x16& p1, const char* K_lds, int r32, int hi, const bf16x8* qr) {
    p0 = f32x16{}; p1 = f32x16{};
    const char* kb[4];
#pragma unroll
    for (int dd = 0; dd < 4; ++dd) kb[dd] = K_lds + KB * SHM_K + KSWZ(r32, (dd * 16 + hi * 8) * 2);
#pragma unroll
    for (int d0 = 0; d0 < 8; ++d0) { const char* a = kb[d0 & 3] + (d0 >> 2) * 128;
        bf16x8 b0 = *reinterpret_cast<const bf16x8*>(a);
        bf16x8 b1 = *reinterpret_cast<const bf16x8*>(a + 32 * 256);
        p0 = __builtin_amdgcn_mfma_f32_32x32x16_bf16(b0, qr[d0], p0, 0, 0, 0);
        p1 = __builtin_amdgcn_mfma_f32_32x32x16_bf16(b1, qr[d0], p1, 0, 0, 0); }
}
template <int VB>
__device__ __forceinline__ void pv_tile(f32x16* o, int vb0, bf16x8 pa0, bf16x8 pa1, bf16x8 pa2, bf16x8 pa3) {
#define TRRD(dst, off) asm volatile("ds_read_b64_tr_b16 %0, %1 offset:%2" : "=&v"(dst) : "v"(vb0), "i"(off) : "memory")
#define PV_D0(d0) do { s16x4 l0, l1, l2, l3, h0, h1, h2, h3; constexpr int b_ = VB * SHM_V + v_rd_off(d0, 0, 0); \
        TRRD(l0, b_); TRRD(h0, b_ + 2048); TRRD(l1, b_ + 4096); TRRD(h1, b_ + 6144); TRRD(l2, b_ + 8192); TRRD(h2, b_ + 10240); TRRD(l3, b_ + 12288); TRRD(h3, b_ + 14336); \
        asm volatile("s_waitcnt lgkmcnt(0)" ::: "memory"); SBAR();   \
        o[d0] = __builtin_amdgcn_mfma_f32_32x32x16_bf16(pa0, (bf16x8){l0[0], l0[1], l0[2], l0[3], h0[0], h0[1], h0[2], h0[3]}, o[d0], 0, 0, 0);   \
        o[d0] = __builtin_amdgcn_mfma_f32_32x32x16_bf16(pa1, (bf16x8){l1[0], l1[1], l1[2], l1[3], h1[0], h1[1], h1[2], h1[3]}, o[d0], 0, 0, 0);   \
        o[d0] = __builtin_amdgcn_mfma_f32_32x32x16_bf16(pa2, (bf16x8){l2[0], l2[1], l2[2], l2[3], h2[0], h2[1], h2[2], h2[3]}, o[d0], 0, 0, 0);   \
        o[d0] = __builtin_amdgcn_mfma_f32_32x32x16_bf16(pa3, (bf16x8){l3[0], l3[1], l3[2], l3[3], h3[0], h3[1], h3[2], h3[3]}, o[d0], 0, 0, 0); } while (0)
    PV_D0(0); PV_D0(1); PV_D0(2); PV_D0(3);
#undef PV_D0
#undef TRRD
}

struct BlockRef { const bf16* Q; const bf16* K; const bf16* V; bf16* O; const unsigned* M; int P0; };
struct Seam { bf16x8 qr[8]; bf16x8 st_v0, st_v1, st_k0, st_k1; };
#define ROW(p, k0, r32c) ((const bf16*)((const char*)(p) + (size_t)((k0) + (r32c)) * (PITCH * 2) + rvo))
#define VMW() asm volatile("s_waitcnt vmcnt(0)" ::: "memory")
#define VMWN(n) asm volatile("s_waitcnt vmcnt(%0)" :: "i"(n) : "memory")
#define SLOAD_H(Kp, Vp, k0) do { S.st_v0 = load8(ROW(Vp, k0, 0)); S.st_v1 = load8(ROW(Vp, k0, 32));              \
                         S.st_k0 = load8(ROW(Kp, k0, 0)); S.st_k1 = load8(ROW(Kp, k0, 32)); } while (0)
#define SWRITE_HK(bf) do { *(bf16x8*)(K_lds + (bf) * SHM_K + kws) = S.st_k0; *(bf16x8*)(K_lds + (bf) * SHM_K + kws + 32 * 256) = S.st_k1; } while (0)
#define SWRITE_HV(bf) do { *(bf16x8*)(V_lds + (bf) * SHM_V + vst0) = S.st_v0; *(bf16x8*)(V_lds + (bf) * SHM_V + vst1) = S.st_v1; } while (0)
#define SWRITE_H(bf) do { SWRITE_HV(bf); SWRITE_HK(bf); } while (0)
__device__ __forceinline__ void mask_dma(const BlockRef& b, char* lds, int wid, int r32, int hi) {
    const int nt = (b.P0 + QB - 1) / KVBLK + 1;
    const char* mg = (const char*)b.M + (unsigned)((wid * QBLK + r32) * 256 + 16 * hi);
    LAS char* ml = (LAS char*)lds + ATT_KV_BYTES + wid * MWAVE;
    for (int jj = 0; jj < (nt + 3) / 4; ++jj) __builtin_amdgcn_global_load_lds((const unsigned*)(mg + 32 * jj), (LAS unsigned*)(ml + 1024 * jj), 16, 0, 0);
}
#define MASK_RD(t) (*(const LAS u32x2*)(mlane + (((t) >> 2) * 1024 + (((t) >> 1) & 1) * 512 + ((t) & 1) * 8)))
__device__ __forceinline__ void attn_prime(const BlockRef& cur, char* lds, Seam& S) {
    const int tid = threadIdx.x, wid = __builtin_amdgcn_readfirstlane(tid >> 6), lane = tid & 63, r32 = lane & 31, hi = lane >> 5;
    const int sr = tid >> 4, sc = (tid & 15) * 8, kws = KSWZ(sr, sc * 2); char* K_lds = lds + 2 * SHM_V; const unsigned rvo = (unsigned)((sr * PITCH + sc) * 2);
#pragma unroll
    for (int d0 = 0; d0 < 8; ++d0) S.qr[d0] = load8((const bf16*)((const char*)cur.Q + (unsigned)(((wid * QBLK + r32) * PITCH + hi * 8) * 2 + d0 * 32)));
    SLOAD_H(cur.K, cur.V, 0); mask_dma(cur, lds, wid, r32, hi); VMW(); SWRITE_HK(0);
    __syncthreads();
}
__device__ __forceinline__ void attn_block(const BlockRef& cur, const BlockRef& nxt, char* lds, Seam& S) {
    const int tid = threadIdx.x, wid = __builtin_amdgcn_readfirstlane(tid >> 6), lane = tid & 63, r32 = lane & 31, hi = lane >> 5;
    const int NT = (cur.P0 + QB - 1) / KVBLK + 1;
    char* V_lds = lds; char* K_lds = lds + 2 * SHM_V;
    float* ws = (float*)(lds + 2 * SHM_V + 2 * SHM_K) + wid * 64; float* li_l = ws, * al_l = ws + 32;
    float m_reg = -1e30f, l_reg = 0; f32x16 o[4] = {};
    const int sr = tid >> 4, sc = (tid & 15) * 8, vst0 = v_st(sr, sc), vst1 = v_st(32 + sr, sc), kws = KSWZ(sr, sc * 2); const unsigned rvo = (unsigned)((sr * PITCH + sc) * 2);
    const int vb0 = (int)(uintptr_t)V_lds + v_rd_base(lane);
    const bf16* Kh = cur.K; const bf16* Vh = cur.V;
    LAS char* mlane = (LAS char*)lds + ATT_KV_BYTES + wid * MWAVE + r32 * 16;
#define RESC(a) do { if (__any((a) < 1.f)) { if (hi == 0) al_l[r32] = (a); asm volatile("s_waitcnt lgkmcnt(0)" ::: "memory");              \
                     for (int d_ = 0; d_ < 4; ++d_) for (int r = 0; r < 16; ++r) o[d_][r] *= al_l[crow(r, hi)]; } } while (0)
#define KBASE(t) ((t) * KVBLK)
#ifdef ATT_NOMASK
#define MASKT(P0_, P1_, mw_) do { } while (0)
#else
#define MASKT(P0_, P1_, mw_) do { unsigned w0_ = (mw_).x, w1_ = (mw_).y; asm volatile("" : "+v"(w0_), "+v"(w1_)); mask_bits(P0_, P1_, w0_, w1_, hi); } while (0)
#endif
    constexpr int NQL = 8;
#define SEAM_K0() do { VMWN(NQL); SWRITE_HK(0); SBAR(); } while (0)
    f32x16 pA0, pA1, pB0, pB1; float mnA, mnB, alA, alB; bf16x8 pa0, pa1, pa2, pa3;
    { SWRITE_HV(0); SBAR();
      SLOAD_H(Kh, Vh, KBASE(1));
      SBAR(); qkt<0>(pA0, pA1, K_lds, r32, hi, S.qr);
      VMWN(4);
      { const u32x2 mw0 = MASK_RD(0); MASKT(pA0, pA1, mw0); } partialSM(pA0, pA1, m_reg, mnA, alA); }
    if (NT > 1) { VMW(); SWRITE_H(1); }
    __syncthreads();
#define HALF_STEP(PX0, PX1, mnX, alX, PY0, PY1, alY, t, KB, VB, SB) do {                                                      \
        SBAR(); qkt<KB>(PX0, PX1, K_lds, r32, hi, S.qr);                                                                      \
        finishSM(PY0, PY1, alY, l_reg, pa0, pa1, pa2, pa3); SBAR();                                                           \
        if ((t) + 1 < NT) { SLOAD_H(Kh, Vh, KBASE((t) + 1)); SBAR(); }                                                        \
        pv_tile<VB>(o, vb0, pa0, pa1, pa2, pa3); { const u32x2 mw_ = MASK_RD(t); MASKT(PX0, PX1, mw_); } partialSM(PX0, PX1, m_reg, mnX, alX);                  \
        __syncthreads();                                                                                                      \
        if ((t) + 1 < NT) { VMW(); SWRITE_H(SB); }                                                                            \
        RESC(alX); __syncthreads(); } while (0)
    for (int t = 1; t + 1 < NT; t += 2) {
        HALF_STEP(pB0, pB1, mnB, alB, pA0, pA1, alA, t, 1, 0, 0);
        HALF_STEP(pA0, pA1, mnA, alA, pB0, pB1, alB, t + 1, 0, 1, 1);
    }
    const bool even = (NT & 1) == 0;
    if (even) { SBAR(); qkt<1>(pB0, pB1, K_lds, r32, hi, S.qr); SBAR(); }
    SLOAD_H(nxt.K, nxt.V, 0); SBAR();
#pragma unroll
    for (int d0 = 0; d0 < 8; ++d0) S.qr[d0] = load8((const bf16*)((const char*)nxt.Q + (unsigned)(((wid * QBLK + r32) * PITCH + hi * 8) * 2 + d0 * 32)));
    SBAR();
    finishSM(pA0, pA1, alA, l_reg, pa0, pa1, pa2, pa3); SBAR();
    pv_tile<0>(o, vb0, pa0, pa1, pa2, pa3);
    if (even) { { const u32x2 mwl = MASK_RD(NT - 1); MASKT(pB0, pB1, mwl); } partialSM(pB0, pB1, m_reg, mnB, alB); __syncthreads(); RESC(alB);
        finishSM(pB0, pB1, alB, l_reg, pa0, pa1, pa2, pa3); SBAR(); pv_tile<1>(o, vb0, pa0, pa1, pa2, pa3); }
    SBAR(); asm volatile("s_waitcnt lgkmcnt(0)" ::: "memory"); mask_dma(nxt, lds, wid, r32, hi); SBAR(); SEAM_K0();
    if (hi == 0) li_l[r32] = l_reg; asm volatile("s_waitcnt lgkmcnt(0)" ::: "memory");
    int tz; asm volatile("v_mbcnt_lo_u32_b32 %0, -1, 0\n\tv_mbcnt_hi_u32_b32 %0, -1, %0" : "=v"(tz)); const int hib = (tz >> 5) & 1, r32b = tz & 31, widb = wid;
    float rli[16];
#pragma unroll
    for (int r = 0; r < 16; ++r) rli[r] = __builtin_amdgcn_rcpf(li_l[crow(r, hib)]);
    unsigned char* Ow = (unsigned char*)cur.O + (unsigned)((widb * QBLK + 4 * hib) * PITCH + 4 * r32b);
#pragma unroll
    for (int r = 0; r < 16; ++r) {
        *(GAS unsigned*)Ow = cvt4_fp8(o[0][r] * rli[r], o[1][r] * rli[r], o[2][r] * rli[r], o[3][r] * rli[r]);
        Ow += ((r & 3) == 3 ? 5 : 1) * PITCH; asm volatile("" : "+v"(Ow)); }
    __syncthreads();
#undef RESC
#undef KBASE
#undef MASKT
#undef SEAM_K0
#undef HALF_STEP
}
#undef ROW
#undef SLOAD_H
#undef SWRITE_HK
#undef SWRITE_HV
#undef SWRITE_H
}

#define XB_TMO      128
#define XB_XCNT(j)  (256  + 64 * (j))
#define XB_XSUB(j)  (1280 + 64 * (j))
#define XB_XGEN(j)  (2304 + 64 * (j))
#define XB_TOP      3328
#define XB_TOPGEN   3392
#define XCD_BAR_WORDS 3456
#define XB_SPIN_CAP (1u << 18)
__device__ __forceinline__ unsigned xb_ld(unsigned* p)              { return __hip_atomic_load(p, __ATOMIC_RELAXED, __HIP_MEMORY_SCOPE_AGENT); }
__device__ __forceinline__ unsigned xb_add(unsigned* p, unsigned v) { return __hip_atomic_fetch_add(p, v, __ATOMIC_RELAXED, __HIP_MEMORY_SCOPE_AGENT); }
__device__ __forceinline__ unsigned xb_xcc_id() { return (unsigned)__builtin_amdgcn_s_getreg((3 << 11) | 20) & 0xFu; }
#define XB_SPIN(cond, bar) do { unsigned _sp = 0; while (cond) { __builtin_amdgcn_s_sleep(1); \
    if ((++_sp & 255u) == 0u) { if (xb_ld(&(bar)[XB_TMO])) break; if (_sp > XB_SPIN_CAP) { atomicAdd(&(bar)[XB_TMO], 1u); break; } } } } while (0)
struct XcdBarrier { unsigned* bar; unsigned x; volatile LAS unsigned* st; };
__device__ __forceinline__ XcdBarrier xcd_barrier_post(unsigned* bar, volatile LAS unsigned* st) {
    XcdBarrier b; b.bar = bar; b.x = xb_xcc_id(); b.st = st;
    if (threadIdx.x == 0) (void)xb_add(&bar[XB_XCNT(b.x)], 1u);
    return b;
}
__device__ __forceinline__ void xcd_barrier_complete(unsigned* bar, unsigned x, unsigned& nloc, unsigned& nx) {
    const unsigned G = gridDim.x * gridDim.y * gridDim.z;
    unsigned sum, cnt, mine, sp = 0u;
    for (;;) {
        sum = 0u; cnt = 0u; mine = 0u;
#pragma unroll
        for (unsigned j = 0; j < 16; ++j) { const unsigned c = xb_ld(&bar[XB_XCNT(j)]); sum += c; cnt += (c > 0u) ? 1u : 0u; mine = (j == x) ? c : mine; }
        if (sum == G) break;
        __builtin_amdgcn_s_sleep(1);
        if ((++sp & 255u) == 0u) { if (xb_ld(&bar[XB_TMO])) break; if (sp > XB_SPIN_CAP) { atomicAdd(&bar[XB_TMO], 1u); break; } }
    }
    nloc = mine > 0u ? mine : 1u; nx = cnt > 0u ? cnt : 1u;
}
__device__ __forceinline__ void xcd_barrier(const XcdBarrier& b) {
    asm volatile("s_waitcnt vmcnt(0)" ::: "memory");
    __syncthreads();
    if (threadIdx.x == 0) {
        unsigned* bar = b.bar;
        __builtin_amdgcn_s_waitcnt(0);
        unsigned nloc = b.st[0], nx = b.st[1];
        if (nloc == 0u) { xcd_barrier_complete(bar, b.x, nloc, nx); b.st[0] = nloc; b.st[1] = nx; }
        const unsigned old = xb_add(&bar[XB_XSUB(b.x)], 1u);
        const unsigned gen = old / nloc;
        if (old + 1u == (gen + 1u) * nloc) {
            __builtin_amdgcn_fence(__ATOMIC_RELEASE, "agent");
            asm volatile("s_waitcnt vmcnt(0)" ::: "memory");
            const unsigned og = xb_add(&bar[XB_TOP], 1u);
            const unsigned tg = og / nx;
            if (og + 1u == (tg + 1u) * nx) xb_add(&bar[XB_TOPGEN], 1u);
            else XB_SPIN(xb_ld(&bar[XB_TOPGEN]) == tg, bar);
            __builtin_amdgcn_fence(__ATOMIC_ACQUIRE, "agent");
            xb_add(&bar[XB_XGEN(b.x)], 1u);
            asm volatile("s_waitcnt vmcnt(0)" ::: "memory");
        } else {
            XB_SPIN(xb_ld(&bar[XB_XGEN(b.x)]) == gen, bar);
            __builtin_amdgcn_fence(__ATOMIC_ACQUIRE, "agent");
            asm volatile("s_waitcnt vmcnt(0)" ::: "memory");
        }
    }
    __syncthreads();
}

struct Args { const float* in[23]; float* out; unsigned char* ws; int ph_lo, ph_hi; };
enum { I_X = 0, I_C, I_WMOD, I_BMOD, I_N1G, I_WIN, I_KVG, I_WUK, I_WUV, I_WPA, I_SGG, I_WSP, I_BSP, I_WPB, I_WOUT, I_N2G, I_WR, I_BR, I_WGU, I_BGU, I_WD, I_BD, I_FG };

struct Frame { LAS unsigned char* lds; int tid, lane, wave, vcu, G; };

template <class SrcF>
__device__ __forceinline__ void transpose_item(const float* W, int ldw, bf16* WT, int ldt, int k0, int n0, LAS float* scr, int lane, SrcF srcf, const float* kscale) {
    const int sc = srcf(n0 + (lane & 31));
    float tv[32];
#pragma unroll
    for (int i = 0; i < 32; ++i) { const int kk = 2 * i + (lane >> 5); tv[i] = W[(size_t)(k0 + kk) * ldw + (sc >= 0 ? sc : 0)]; }
#pragma unroll
    for (int i = 0; i < 32; ++i) { const int kk = 2 * i + (lane >> 5); float v = sc >= 0 ? tv[i] : 0.f; if (kscale) v *= kscale[k0 + kk]; scr[kk * 33 + (lane & 31)] = v; }
    LDS_WAIT(); asm volatile("" ::: "memory");
    const int c = lane & 7;
#pragma unroll
    for (int j = 0; j < 4; ++j) { const int n = (lane >> 3) + 8 * j; const LAS float* s = scr + (8 * c) * 33 + n;
        u32x4 o; o.x = cvtpk(s[0 * 33], s[1 * 33]); o.y = cvtpk(s[2 * 33], s[3 * 33]); o.z = cvtpk(s[4 * 33], s[5 * 33]); o.w = cvtpk(s[6 * 33], s[7 * 33]);
        *(u32x4*)(WT + (size_t)(n0 + n) * ldt + k0 + 8 * c) = o; }
    LDS_WAIT(); asm volatile("" ::: "memory");
}

template <bool F8, class DRow>
__device__ __forceinline__ void conv_item(const float* W, int ldw, int N, void* WT, int ldt, int k0, int c0, int lane, DRow drow, float scale) {
    constexpr int KS = F8 ? 16 : 8, NSTEP = 8;
    const int c = c0 + 4 * lane; const bool ok = c + 3 < N;
    const float* src = W + (size_t)k0 * ldw + (ok ? c : 0);
    char* dp[4];
#pragma unroll
    for (int j = 0; j < 4; ++j) dp[j] = (char*)WT + ((size_t)drow(ok ? c + j : 0) * ldt + k0) * (F8 ? 1 : 2);
    f32x4 cur[KS], nxt[KS];
#pragma unroll
    for (int i = 0; i < KS; ++i) cur[i] = *(const f32x4*)(src + (size_t)i * ldw);
#pragma unroll
    for (int st = 0; st < NSTEP; ++st) {
        if (st + 1 < NSTEP) {
#pragma unroll
            for (int i = 0; i < KS; ++i) nxt[i] = *(const f32x4*)(src + (size_t)((st + 1) * KS + i) * ldw); }
#pragma unroll
        for (int j = 0; j < 4; ++j) { u32x4 o;
            if constexpr (F8) { o.x = cvt4_fp8(cur[0][j] * scale, cur[1][j] * scale, cur[2][j] * scale, cur[3][j] * scale); o.y = cvt4_fp8(cur[4][j] * scale, cur[5][j] * scale, cur[6][j] * scale, cur[7][j] * scale);
                                o.z = cvt4_fp8(cur[8][j] * scale, cur[9][j] * scale, cur[10][j] * scale, cur[11][j] * scale); o.w = cvt4_fp8(cur[12][j] * scale, cur[13][j] * scale, cur[14][j] * scale, cur[15][j] * scale); }
            else { o.x = cvtpk(cur[0][j], cur[1][j]); o.y = cvtpk(cur[2][j], cur[3][j]); o.z = cvtpk(cur[4][j], cur[5][j]); o.w = cvtpk(cur[6][j], cur[7][j]); }
            if (ok) *(u32x4*)(dp[j] + st * 16) = o; }
        if (st + 1 < NSTEP) {
#pragma unroll
            for (int i = 0; i < KS; ++i) cur[i] = nxt[i]; }
    }
}

template <class SrcF>
__device__ __forceinline__ void transpose_item8(const float* W, int ldw, unsigned char* WT, int ldt, int k0, int n0, LAS float* scr, int lane, SrcF srcf, float scale) {
    const int sc = srcf(n0 + (lane & 31));
    float tv[64];
#pragma unroll
    for (int i = 0; i < 64; ++i) { const int kk = 2 * i + (lane >> 5); tv[i] = W[(size_t)(k0 + kk) * ldw + sc]; }
#pragma unroll
    for (int i = 0; i < 64; ++i) { const int kk = 2 * i + (lane >> 5); scr[kk * 33 + (lane & 31)] = tv[i] * scale; }
    LDS_WAIT(); asm volatile("" ::: "memory");
    const int c = lane & 7;
#pragma unroll
    for (int j = 0; j < 4; ++j) { const int n = (lane >> 3) + 8 * j; const LAS float* s = scr + (16 * c) * 33 + n;
        u32x4 o; o.x = cvt4_fp8(s[0 * 33], s[1 * 33], s[2 * 33], s[3 * 33]); o.y = cvt4_fp8(s[4 * 33], s[5 * 33], s[6 * 33], s[7 * 33]);
        o.z = cvt4_fp8(s[8 * 33], s[9 * 33], s[10 * 33], s[11 * 33]); o.w = cvt4_fp8(s[12 * 33], s[13 * 33], s[14 * 33], s[15 * 33]);
        *(u32x4*)(WT + (size_t)(n0 + n) * ldt + k0 + 16 * c) = o; }
    LDS_WAIT(); asm volatile("" ::: "memory");
}

__device__ __forceinline__ void moe_conv(const Frame& F, const Args& a) {
    unsigned char* ws = a.ws;
    { constexpr int TPE_GU = 16 * 32, TPE_DN = 16 * 16, NT_GU = NE * TPE_GU, NTILE = NT_GU + NE * TPE_DN;
      LAS unsigned char* fb = F.lds;
      LAS unsigned* stg = (LAS unsigned*)(F.lds + 131072);
      auto issue = [&](int t, int buf) {
          const float* W; int ldw, k0, c0;
          if (t < NT_GU) { const int e = t / TPE_GU, q = t % TPE_GU; W = a.in[I_WGU] + (size_t)e * D * (2 * DFF); ldw = 2 * DFF; k0 = 128 * (q & 15); c0 = 128 * (q >> 4); }
          else { const int r = t - NT_GU, e = r / TPE_DN, q = r % TPE_DN; W = a.in[I_WD] + (size_t)e * DFF * D; ldw = D; k0 = 128 * (q & 15); c0 = 128 * (q >> 4); }
          const float* p = W + (size_t)(k0 + 16 * F.wave + (F.lane >> 5)) * ldw + c0 + 4 * (F.lane & 31);
#pragma unroll
          for (int i = 0; i < 8; ++i)
              __builtin_amdgcn_global_load_lds((const unsigned*)(p + (size_t)(2 * i) * ldw), (LAS unsigned*)(fb + buf * 65536 + (16 * F.wave + 2 * i) * 512), 16, 0, 2); };
      auto convert = [&](int buf) {
          const LAS unsigned char* src = fb + buf * 65536 + (16 * F.wave) * 512 + F.lane * 8;
          f32x2 v[16];
#pragma unroll
          for (int r = 0; r < 16; ++r) v[r] = *(const LAS f32x2*)(src + r * 512);
#pragma unroll
          for (int kq = 0; kq < 4; ++kq) { u32x2 w;
              w.x = cvt4_fp8(v[4 * kq][0] * W8_SCALE, v[4 * kq + 1][0] * W8_SCALE, v[4 * kq + 2][0] * W8_SCALE, v[4 * kq + 3][0] * W8_SCALE);
              w.y = cvt4_fp8(v[4 * kq][1] * W8_SCALE, v[4 * kq + 1][1] * W8_SCALE, v[4 * kq + 2][1] * W8_SCALE, v[4 * kq + 3][1] * W8_SCALE);
              *(LAS u32x2*)(stg + (4 * F.wave + kq) * 128 + 2 * F.lane) = w; } };
      auto store_tile = [&](int t) {
          unsigned char* WT; int ldt, k0, c0; const bool gu = t < NT_GU;
          if (gu) { const int e = t / TPE_GU, q = t % TPE_GU; WT = (unsigned char*)(ws + WS_WGU) + (size_t)e * (2 * DFF) * D; ldt = D; k0 = 128 * (q & 15); c0 = 128 * (q >> 4); }
          else { const int r = t - NT_GU, e = r / TPE_DN, q = r % TPE_DN; WT = (unsigned char*)(ws + WS_WD) + (size_t)e * D * DFF; ldt = DFF; k0 = 128 * (q & 15); c0 = 128 * (q >> 4); }
          const int c = F.tid & 7;
#pragma unroll
          for (int j = 0; j < 2; ++j) { const int nl = (F.tid >> 3) + 64 * j, n = c0 + nl; const LAS unsigned* sp = stg + (4 * c) * 128 + nl;
              u32x4 o; o.x = sp[0]; o.y = sp[128]; o.z = sp[256]; o.w = sp[384];
              const int drow = gu ? (((n & 2047) >> 7) * 256 + (n >> 11) * 128 + (n & 127)) : n;
              __builtin_nontemporal_store(o, (u32x4*)(WT + (size_t)drow * ldt + k0 + 16 * c)); } };
#define MC_STEP(s_, buf_) do { if ((s_) > 0) store_tile(tix((s_) - 1)); LDS_BARRIER(); \
          asm volatile("s_waitcnt vmcnt(8)" ::: "memory"); convert(buf_); asm volatile("s_waitcnt lgkmcnt(0)" ::: "memory"); issue(tix((s_) + 2), buf_); LDS_BARRIER(); } while (0)
      const int t0 = F.vcu, nw = t0 < NTILE ? (NTILE - 1 - t0) / F.G + 1 : 0;
      if (nw > 0) {
          const int tl = t0 + (nw - 1) * F.G;
          auto tix = [&](int s) { const int x = t0 + s * F.G; return x < tl ? x : tl; };
          issue(tix(0), 0); issue(tix(1), 1);
#pragma unroll 1
          for (int s = 0; s < nw; s += 2) { MC_STEP(s, 0); MC_STEP(s + 1, 1); }
          store_tile(tl);
          VM_WAIT(); }
#undef MC_STEP
      __syncthreads(); }
}

__device__ __forceinline__ void win_conv(const Frame& F, const Args& a) {
    unsigned char* ws = a.ws;
    constexpr int NT_B = 16 * (NIN_B / 128), NT_A = 16 * (NIN_A / 128), NT_SQ = 16 * 16, NTILE = NT_B + NT_A + 3 * NT_SQ;
    LAS unsigned char* fb = F.lds;
    LAS unsigned* stg = (LAS unsigned*)(F.lds + 131072);
    auto decode = [&](int t, const float*& src, int& ldw, int& valid, unsigned char*& dst) {
        if (t < NT_B) { const int kb = t & 15, n0 = 128 * (t >> 4); src = a.in[I_WIN] + (size_t)(128 * kb) * NIN_SRC + (n0 < 2304 ? n0 : n0 + 2192); ldw = NIN_SRC; valid = 128;
            dst = (unsigned char*)(ws + WS_WIN8) + (size_t)n0 * D + 128 * kb; return; }
        t -= NT_B;
        if (t < NT_A) { const int kb = t & 15, n0 = 128 * (t >> 4); src = a.in[I_WIN] + (size_t)(128 * kb) * NIN_SRC + n0 + 2304; ldw = NIN_SRC; valid = 2192 - n0 < 128 ? 2192 - n0 : 128;
            dst = (unsigned char*)(ws + WS_WIN) + (size_t)n0 * D + 128 * kb; return; }
        t -= NT_A;
        { const int w = t / NT_SQ, q = t % NT_SQ, kb = q & 15, n0 = 128 * (q >> 4);
          src = (w == 0 ? a.in[I_WPA] : (w == 1 ? a.in[I_WPB] : a.in[I_WOUT])) + (size_t)(128 * kb) * D + n0; ldw = D; valid = 128;
          dst = (unsigned char*)(ws + (w == 0 ? WS_WPA : (w == 1 ? WS_WPB : WS_WOUT))) + (size_t)n0 * D + 128 * kb; } };
    auto issue = [&](int t, int buf) {
        const float* src; int ldw, valid; unsigned char* dst; decode(t, src, ldw, valid, dst);
        int col = 4 * (F.lane & 31); col = col < valid ? col : valid - 4;
        const float* p = src + (size_t)(16 * F.wave + (F.lane >> 5)) * ldw + col;
#pragma unroll
        for (int i = 0; i < 8; ++i)
            __builtin_amdgcn_global_load_lds((const unsigned*)(p + (size_t)(2 * i) * ldw), (LAS unsigned*)(fb + buf * 65536 + (16 * F.wave + 2 * i) * 512), 16, 0, 0); };
    auto convert = [&](int buf) {
        const LAS unsigned char* s = fb + buf * 65536 + (16 * F.wave) * 512 + F.lane * 8;
        f32x2 v[16];
#pragma unroll
        for (int r = 0; r < 16; ++r) v[r] = *(const LAS f32x2*)(s + r * 512);
#pragma unroll
        for (int kq = 0; kq < 4; ++kq) { u32x2 w;
            w.x = cvt4_fp8(v[4 * kq][0] * W8_SCALE, v[4 * kq + 1][0] * W8_SCALE, v[4 * kq + 2][0] * W8_SCALE, v[4 * kq + 3][0] * W8_SCALE);
            w.y = cvt4_fp8(v[4 * kq][1] * W8_SCALE, v[4 * kq + 1][1] * W8_SCALE, v[4 * kq + 2][1] * W8_SCALE, v[4 * kq + 3][1] * W8_SCALE);
            *(LAS u32x2*)(stg + (4 * F.wave + kq) * 128 + 2 * F.lane) = w; } };
    auto store_tile = [&](int t) {
        const float* src; int ldw, valid; unsigned char* dst; decode(t, src, ldw, valid, dst);
        const int c = F.tid & 7;
#pragma unroll
        for (int j = 0; j < 2; ++j) { const int nl = (F.tid >> 3) + 64 * j; const LAS unsigned* sp = stg + (4 * c) * 128 + nl;
            u32x4 o; o.x = sp[0]; o.y = sp[128]; o.z = sp[256]; o.w = sp[384];
            *(u32x4*)(dst + (size_t)nl * D + 16 * c) = o; } };
#define WC_STEP(s_, buf_) do { if ((s_) > 0) store_tile(tix((s_) - 1)); LDS_BARRIER(); \
        asm volatile("s_waitcnt vmcnt(8)" ::: "memory"); convert(buf_); asm volatile("s_waitcnt lgkmcnt(0)" ::: "memory"); issue(tix((s_) + 2), buf_); LDS_BARRIER(); } while (0)
    const int t0 = F.vcu, nw = t0 < NTILE ? (NTILE - 1 - t0) / F.G + 1 : 0;
    if (nw > 0) {
        const int tl = t0 + (nw - 1) * F.G;
        auto tix = [&](int s) { const int x = t0 + s * F.G; return x < tl ? x : tl; };
        issue(tix(0), 0); issue(tix(1), 1);
#pragma unroll 1
        for (int s = 0; s < nw; s += 2) { WC_STEP(s, 0); WC_STEP(s + 1, 1); }
        store_tile(tl);
        VM_WAIT(); }
#undef WC_STEP
    __syncthreads();
}


__device__ __forceinline__ void p0_prologue(const Frame& F, const Args& a) {
    unsigned char* ws = a.ws;
    const int gw = F.vcu * NWAVES + F.wave, NGW = F.G * NWAVES;
    {
    LAS float* csil = (LAS float*)F.lds;
    { float cv[32];
#pragma unroll
      for (int q = 0; q < 32; ++q) cv[q] = a.in[I_C][F.tid + q * (NWAVES * 64)];
#pragma unroll
      for (int q = 0; q < 32; ++q) csil[F.tid + q * (NWAVES * 64)] = cv[q] * sigmoidf_(cv[q]); }
    __syncthreads();
    { float* MODP = (float*)(ws + WS_MODP); const float* wm = a.in[I_WMOD];
      for (int task = gw; task < KC * 192; task += NGW) { const int kc = task / 192, ch = task % 192, n = ch * 64 + F.lane, kb = kc * (D / KC);
          float acc[NB];
#pragma unroll
          for (int b = 0; b < NB; ++b) acc[b] = 0.f;
#pragma unroll 64
          for (int k = 0; k < D / KC; ++k) { const float wv = wm[(size_t)(kb + k) * (6 * D) + n];
#pragma unroll
              for (int b = 0; b < NB; ++b) acc[b] = fmaf(csil[b * D + kb + k], wv, acc[b]); }
#pragma unroll
          for (int b = 0; b < NB; ++b) MODP[((size_t)kc * NB + b) * (6 * D) + n] = acc[b]; } }
    __syncthreads(); }
    LAS float* scr = (LAS float*)(F.lds + F.wave * 18432);
    constexpr int I_IN = 16 * (NIN_A / 32);
    constexpr int I_IN8 = 16 * (NIN_B / 32);
    constexpr int I_SQ = 16 * (D / 32);
    constexpr int I_UV = 16 * 4 * 4;
    constexpr int I_RT = 32;
    constexpr int NITEMS = I_IN + I_IN8 + 3 * I_SQ + I_UV;
    for (int it = gw; it < I_UV; it += NGW) { const int r = it;
        { const int h = r / 16, q = r % 16, kb = q / 4, nb = q % 4;
          transpose_item(a.in[I_WUV] + (size_t)h * 256 * 128, 128, (bf16*)(ws + WS_WKV) + (size_t)(2048 + h * 128) * 256, 256, 64 * kb, 32 * nb, scr, F.lane, [](int np) { return (np & 31) * 4 + (np >> 5); }, a.in[I_KVG]); }
    }
    __syncthreads();
    win_conv(F, a);
    __syncthreads();
    const int gt = F.vcu * (NWAVES * 64) + F.tid, NGT = F.G * NWAVES * 64;
    { bf16* wkv = (bf16*)(ws + WS_WKV); const float* wuk = a.in[I_WUK]; const float* kvg = a.in[I_KVG];
      for (int i = gt; i < 2048 * 256 / 2; i += NGT) { const int e0 = 2 * i, c = e0 & 255; ((unsigned*)wkv)[i] = cvtpk(wuk[e0] * kvg[c], wuk[e0 + 1] * kvg[c + 1]); } }
    { bf16* wsp = (bf16*)(ws + WS_WSP); const float* w = a.in[I_WSP];
      for (int i = gt; i < 8 * 128 * 128 / 2; i += NGT) { const int e0 = 2 * i, s = e0 & 127, t = (e0 >> 7) & 127;
          ((unsigned*)wsp)[i] = cvtpk(s <= t ? w[e0] : 0.f, (s + 1) <= t ? w[e0 + 1] : 0.f); } }
    { bf16* wrt = (bf16*)(ws + WS_WRT); const float* w = a.in[I_WR];
      for (int i = gt; i < NE * D; i += NGT) { const int e = i / D, k = i % D; const float v = w[(size_t)k * NE + e]; const unsigned h = cvtpk(v, 0.f) & 0xffffu; const float r = v - bf2f((unsigned short)h);
          wrt[i] = (bf16)h; wrt[NE * D + i] = (bf16)(cvtpk(r, 0.f) & 0xffffu); } }
}

template <bool LO>
__device__ __forceinline__ void norm_mod_rows_unit(const Frame& F, const Args& a, int unit, const float* X, const float* gain, int sc_off, int sh_off, bf16* H, bf16* HLO, const float* modf, unsigned char* H8 = nullptr) {
    const int b = unit / 32, row0 = unit * 64;
    LAS float* av = (LAS float*)F.lds; LAS float* sv = av + D;
    const float* MODP = (const float*)(a.ws + WS_MODP); const float* bm = a.in[I_BMOD];
    if (modf) { const float* mf = modf + (size_t)b * (6 * D); float gk[4], sk[4], hk[4];
#pragma unroll
        for (int q = 0; q < 4; ++q) { const int k = F.tid + q * (NWAVES * 64); gk[q] = gain[k]; sk[q] = mf[sc_off + k]; hk[q] = mf[sh_off + k]; }
#pragma unroll
        for (int q = 0; q < 4; ++q) { const int k = F.tid + q * (NWAVES * 64); av[k] = gk[q] * (1.0f + sk[q]); sv[k] = hk[q]; } }
    else {
#pragma unroll
        for (int k = F.tid; k < D; k += NWAVES * 64) { float sc = bm[sc_off + k], sh = bm[sh_off + k];
#pragma unroll
            for (int kc = 0; kc < KC; ++kc) { const float* p = MODP + ((size_t)kc * NB + b) * (6 * D); sc += p[sc_off + k]; sh += p[sh_off + k]; }
            av[k] = gain[k] * (1.0f + sc); sv[k] = sh; } }
    __syncthreads();
    for (int rr = F.wave * 2; rr < 64; rr += NWAVES * 2) {
        f32x4 v[2][8]; float s[2] = {0.f, 0.f};
#pragma unroll
        for (int q = 0; q < 2; ++q) { const f32x4* xr = (const f32x4*)(X + (size_t)(row0 + rr + q) * D) + F.lane;
#pragma unroll
            for (int j = 0; j < 8; ++j) v[q][j] = xr[64 * j]; }
#pragma unroll
        for (int q = 0; q < 2; ++q)
#pragma unroll
            for (int j = 0; j < 8; ++j) s[q] += (v[q][j][0] * v[q][j][0] + v[q][j][1] * v[q][j][1]) + (v[q][j][2] * v[q][j][2] + v[q][j][3] * v[q][j][3]);
#pragma unroll
        for (int q = 0; q < 2; ++q) { const int row = row0 + rr + q;
            const float rstd = 1.0f / sqrtf(wave_sum(s[q]) * (1.0f / D) + EPS);
            u32x2* o8 = (u32x2*)(H + (size_t)row * D) + F.lane; u32x2* l8 = (u32x2*)(HLO + (size_t)row * D) + F.lane;
#pragma unroll
            for (int j = 0; j < 8; ++j) { const f32x4 aa = ((const LAS f32x4*)av)[F.lane + 64 * j], ss = ((const LAS f32x4*)sv)[F.lane + 64 * j];
                const f32x4 y = (v[q][j] * rstd) * aa + ss; u32x2 w; w.x = cvtpk(y[0], y[1]); w.y = cvtpk(y[2], y[3]); if (H) o8[64 * j] = w;
                if (H8) ((unsigned*)(H8 + (size_t)row * D))[F.lane + 64 * j] = cvt4_fp8(y[0], y[1], y[2], y[3]);
                if (LO) { u32x2 l; l.x = cvtpk(y[0] - bflo(w.x), y[1] - bfhi(w.x)); l.y = cvtpk(y[2] - bflo(w.y), y[3] - bfhi(w.y)); l8[64 * j] = l; } } }
    }
    __syncthreads();
}

__device__ __forceinline__ void idx_scores_unit(const Frame& F, const Args& a, int b, int qt) {
    const bf16* QI = (const bf16*)(a.ws + WS_QI); const bf16* KI = (const bf16*)(a.ws + WS_KI); const float* WI = (const float*)(a.ws + WS_WI); float* SC = (float*)(a.ws + WS_SC);
    const int lane = F.lane, i = lane & 31, kg = lane >> 5;
    const int qbase = qt * 32 + 4 * F.wave;
    const int head = (i & 3) + 4 * (i >> 3), qsel = (i >> 2) & 1;
    bf16x8 af[2][8]; float w[2][16];
#pragma unroll
    for (int p = 0; p < 2; ++p) {
        const bf16* src = QI + (size_t)(b * SEQ + qbase + 2 * p + qsel) * D + head * 128 + kg * 8;
#pragma unroll
        for (int ks = 0; ks < 8; ++ks) af[p][ks] = *(const bf16x8*)(src + ks * 16);
        const float* wp = WI + (size_t)(b * SEQ + qbase + 2 * p + kg) * 16;
#pragma unroll
        for (int r4 = 0; r4 < 4; ++r4) { const f32x4 t = *(const f32x4*)(wp + 4 * r4); w[p][4 * r4] = t[0]; w[p][4 * r4 + 1] = t[1]; w[p][4 * r4 + 2] = t[2]; w[p][4 * r4 + 3] = t[3]; }
    }
    const int kend = 64 * ((qt * 32) / 64 + 1), ntile = kend / 32;
    constexpr int KPITCH = 272, KBUF = 32 * KPITCH;
    LAS char* kl = (LAS char*)F.lds;
    const bf16* kg_src = KI + (size_t)(b * SEQ + (F.tid >> 4)) * 128 + (F.tid & 15) * 8;
    const int kl_dst = (F.tid >> 4) * KPITCH + (F.tid & 15) * 16, kl_src = i * KPITCH + kg * 16;
    LAS float* swin = (LAS float*)(F.lds + 32768 + F.wave * 4096);
#pragma unroll
    for (int p = 0; p < 2; ++p) {
#pragma unroll
        for (int ks = 0; ks < 8; ++ks) asm volatile("" :: "v"(af[p][ks]));
#pragma unroll
        for (int r = 0; r < 16; ++r) asm volatile("" :: "v"(w[p][r])); }
    bf16x8 r0, r1;
#define IDX_GLOAD(dst, t_) asm volatile("global_load_dwordx4 %0, %1, off" : "=v"(dst) : "v"(kg_src + (size_t)((t_) * 32) * 128) : "memory")
    { const bf16x8 t0 = *(const bf16x8*)kg_src; *(LAS bf16x8*)(kl + kl_dst) = t0; }
    IDX_GLOAD(r0, 1);
    LDS_BARRIER();
#define IDX_STEP(t, RCUR, RNXT) do {                                                                                               \
        if ((t) + 2 < ntile) IDX_GLOAD(RNXT, (t) + 2);                                                                             \
        bf16x8 bfr[8];                                                                                                             \
        _Pragma("unroll") for (int ks = 0; ks < 8; ++ks) bfr[ks] = *(const LAS bf16x8*)(kl + ((t) & 1) * KBUF + kl_src + ks * 32);  \
        _Pragma("unroll") for (int p = 0; p < 2; ++p) { f32x16 acc = {};                                                           \
            _Pragma("unroll") for (int ks = 0; ks < 8; ++ks) acc = __builtin_amdgcn_mfma_f32_32x32x16_bf16(af[p][ks], bfr[ks], acc, 0, 0, 0); \
            float sc_ = 0.f;                                                                                                       \
            _Pragma("unroll") for (int r = 0; r < 16; ++r) sc_ = fmaf(fmaxf(acc[r], 0.f), w[p][r], sc_);                            \
            swin[(2 * p + kg) * 256 + ((t) & 7) * 32 + i] = sc_; }                 \
        if ((t) + 1 < ntile) { if ((t) + 2 < ntile) asm volatile("s_waitcnt vmcnt(1)" ::: "memory"); else asm volatile("s_waitcnt vmcnt(0)" ::: "memory"); \
            *(LAS bf16x8*)(kl + (((t) + 1) & 1) * KBUF + kl_dst) = RCUR; }                                                        \
        if (((t) & 7) == 7 || (t) == ntile - 1) {                                \
            const int w0 = ((t) & ~7) * 32; f32x4 fl[4];                                                                           \
            _Pragma("unroll") for (int q = 0; q < 4; ++q) fl[q] = *(const LAS f32x4*)(swin + q * 256 + 4 * lane);                  \
            _Pragma("unroll") for (int q = 0; q < 4; ++q) *(f32x4*)(SC + (size_t)(b * SEQ + qbase + q) * SEQ + w0 + 4 * lane) = fl[q]; } \
        LDS_BARRIER(); } while (0)
    for (int t = 0; t < ntile; t += 2) { IDX_STEP(t, r0, r1); IDX_STEP(t + 1, r1, r0); }
#undef IDX_STEP
#undef IDX_GLOAD
    VM_WAIT(); __syncthreads();
}

__device__ __forceinline__ void topk_mask_row(const Frame& F, const Args& a, int t) {
    const float* SC = (const float*)(a.ws + WS_SC) + (size_t)t * SEQ; unsigned* MK = (unsigned*)(a.ws + WS_MASK) + (size_t)t * 64;
    const int s = t & (SEQ - 1), nj = s / 64 + 1;
    if (nj * 64 <= KSEL) { MK[F.lane] = (F.lane * 32 < nj * 64) ? 0xffffffffu : 0u; return; }
    unsigned u[32];
    { float raw[32];
#pragma unroll
      for (int j = 0; j < 32; ++j) raw[j] = SC[(j < nj ? j : nj - 1) * 64 + F.lane];
#pragma unroll
      for (int j = 0; j < 32; ++j) { const unsigned bits = __float_as_uint(raw[j]); const unsigned key = bits ^ ((unsigned)((int)bits >> 31) | 0x80000000u); const unsigned keep = (unsigned)-(int)(j < nj); u[j] = key & keep; } }
    constexpr int LOWB = 18;
    unsigned prefix = 0u; int cntp = 0; bool done = false;
    for (int bit = 31; bit >= LOWB; --bit) { const unsigned cand = prefix | (1u << bit); int cnt = 0;
#pragma unroll
        for (int c8 = 0; c8 < 4; ++c8) if (nj > 8 * c8) {
#pragma unroll
            for (int j = 8 * c8; j < 8 * c8 + 8; ++j) cnt += __builtin_popcountll(__ballot(u[j] >= cand)); }
        if (cnt >= KSEL) { prefix = cand; cntp = cnt; if (cnt == KSEL) { done = true; break; } } }
    if (!done) {
        if (cntp == 0) { cntp = 0;
#pragma unroll
            for (int j = 0; j < 32; ++j) cntp += __builtin_popcountll(__ballot(u[j] >= 1u)); }
        const unsigned hic = prefix + (1u << LOWB); int cnt_hi = 0;
        if (hic > prefix) {
#pragma unroll
            for (int c8 = 0; c8 < 4; ++c8) if (nj > 8 * c8) {
#pragma unroll
                for (int j = 8 * c8; j < 8 * c8 + 8; ++j) cnt_hi += __builtin_popcountll(__ballot(u[j] >= hic)); } }
        const int namb = cntp - cnt_hi;
        if (namb <= 128) {
            LAS unsigned* cb = (LAS unsigned*)(F.lds + 98304 + F.wave * 512); int base = 0;
#pragma unroll
            for (int j = 0; j < 32; ++j) { const bool amb = (u[j] - prefix) < (1u << LOWB) && u[j] >= prefix; const unsigned long long mk = __ballot(amb);
                const int pos = base + (int)__builtin_amdgcn_mbcnt_hi((unsigned)(mk >> 32), __builtin_amdgcn_mbcnt_lo((unsigned)mk, 0u));
                if (amb) cb[pos] = u[j];
                base += __builtin_popcountll(mk); }
            const unsigned c0 = F.lane < namb ? cb[F.lane] : 0u, c1 = F.lane + 64 < namb ? cb[F.lane + 64] : 0u;
            for (int bit = LOWB - 1; bit >= 0; --bit) { const unsigned cand = prefix | (1u << bit);
                const int cnt = cnt_hi + __builtin_popcountll(__ballot(c0 >= cand)) + __builtin_popcountll(__ballot(c1 >= cand));
                if (cnt >= KSEL) { prefix = cand; if (cnt == KSEL) break; } }
        } else {
            for (int bit = LOWB - 1; bit >= 0; --bit) { const unsigned cand = prefix | (1u << bit); int cnt = 0;
#pragma unroll
                for (int c8 = 0; c8 < 4; ++c8) if (nj > 8 * c8) {
#pragma unroll
                    for (int j = 8 * c8; j < 8 * c8 + 8; ++j) cnt += __builtin_popcountll(__ballot(u[j] >= cand)); }
                if (cnt >= KSEL) { prefix = cand; if (cnt == KSEL) break; } } }
    }
#pragma unroll
    for (int j = 0; j < 32; ++j) { const unsigned long long bal = __ballot(u[j] >= prefix);
        if (F.lane == 0) { u32x2 w; w.x = (unsigned)bal; w.y = (unsigned)(bal >> 32); *(u32x2*)(MK + 2 * j) = w; } }
}

__device__ __forceinline__ void spatial_group(const Frame& F, const Args& a, int b, int n, int gh) {
    using namespace att;
    const bf16* V = (const bf16*)(a.ws + WS_V); const bf16* U = (const bf16*)(a.ws + WS_U); unsigned char* SG8 = (unsigned char*)(a.ws + WS_SG);
    char* lds = (char*)F.lds;
    const int tid = F.tid, lane = F.lane, r32 = lane & 31, hi = lane >> 5, tt = F.wave & 3, dh = F.wave >> 2;
    const int tok0 = b * SEQ + n * 128, sr = tid >> 4, sc = (tid & 15) * 8;
    LAS f32x2* stat = (LAS f32x2*)(lds + 4 * SHM_V);
    { const int row = tid >> 2, q = tid & 3; const f32x4* p = (const f32x4*)((const float*)(a.ws + WS_VST) + ((size_t)(tok0 + row) * 32 + q * 8) * 2);
      const f32x4 p0 = p[0], p1 = p[1], p2 = p[2], p3 = p[3];
      float s1 = (p0[0] + p0[2]) + (p1[0] + p1[2]) + (p2[0] + p2[2]) + (p3[0] + p3[2]), s2 = (p0[1] + p0[3]) + (p1[1] + p1[3]) + (p2[1] + p2[3]) + (p3[1] + p3[3]);
      s1 += __shfl_xor(s1, 1); s1 += __shfl_xor(s1, 2); s2 += __shfl_xor(s2, 1); s2 += __shfl_xor(s2, 2);
      const float mean = s1 * (1.0f / D), var = fmaxf(s2 * (1.0f / D) - mean * mean, 0.f);
      if (q == 0) stat[row] = (f32x2){mean, 1.0f / sqrtf(var + EPS)}; }
    bf16x8 xr[4][2]; f32x4 gn[2][2];
#define SP_LOAD(g_) do { _Pragma("unroll") for (int tl = 0; tl < 4; ++tl) { const int dhh = tl >> 1, kh = tl & 1; const bf16* src = V + (size_t)(tok0 + 64 * kh) * D + (g_) * 256 + 128 * dhh + sc; \
          xr[tl][0] = *(const bf16x8*)(src + (size_t)sr * D); xr[tl][1] = *(const bf16x8*)(src + (size_t)(32 + sr) * D); } \
      _Pragma("unroll") for (int dhh = 0; dhh < 2; ++dhh) { const float* gp = a.in[I_SGG] + (g_) * 256 + 128 * dhh + sc; gn[dhh][0] = *(const f32x4*)gp; gn[dhh][1] = *(const f32x4*)(gp + 4); } } while (0)
    SP_LOAD(4 * gh);
    const int vb0 = (int)(uintptr_t)lds + v_rd_base(lane);
#pragma unroll 1
    for (int i = 0; i < 4; ++i) { const int g = 4 * gh + i;
        const bf16* WSP = (const bf16*)(a.ws + WS_WSP) + (size_t)g * 128 * 128; const float* bsp = a.in[I_BSP] + g * 128;
        bf16x8 pa[8];
        { const bf16* wp = WSP + (size_t)(32 * tt + r32) * 128 + 8 * hi;
#pragma unroll
          for (int ks = 0; ks < 8; ++ks) pa[ks] = *(const bf16x8*)(wp + 16 * ks); }
        LDS_BARRIER();
#pragma unroll
        for (int tl = 0; tl < 4; ++tl) { const int dhh = tl >> 1, kh = tl & 1;
#pragma unroll
            for (int h2 = 0; h2 < 2; ++h2) { const int rl = 64 * kh + 32 * h2 + sr; const f32x2 ms = stat[rl]; f32x4 x0, x1; pg8::unpack8(__builtin_bit_cast(u32x4, xr[tl][h2]), x0, x1);
                const f32x4 y0 = (x0 - ms.x) * ms.y * gn[dhh][0], y1 = (x1 - ms.x) * ms.y * gn[dhh][1];
#pragma unroll
                for (int d0 = 0; d0 < 4; ++d0) *(unsigned*)(lds + tl * SHM_V + v_st(32 * h2 + sr, d0 * 32 + (sc >> 2))) = cvtpk(y0[d0], y1[d0]); } }
        if (i < 3) SP_LOAD(g + 1);
        LDS_BARRIER();
        f32x16 o[4] = {};
        if (dh == 0) { pv_tile<0>(o, vb0, pa[0], pa[1], pa[2], pa[3]); pv_tile<1>(o, vb0, pa[4], pa[5], pa[6], pa[7]); }
        else         { pv_tile<2>(o, vb0, pa[0], pa[1], pa[2], pa[3]); pv_tile<3>(o, vb0, pa[4], pa[5], pa[6], pa[7]); }
        float bb[16]; u32x2 uu[16];
#pragma unroll
        for (int r = 0; r < 16; ++r) { const int tl = 32 * tt + crow(r, hi); bb[r] = bsp[tl]; uu[r] = *(const u32x2*)(U + (size_t)(tok0 + tl) * D + g * 256 + dh * 128 + 4 * r32); }
#pragma unroll
        for (int r = 0; r < 16; ++r) { const int tl = 32 * tt + crow(r, hi); const size_t rowoff = (size_t)(tok0 + tl) * D + g * 256 + dh * 128 + 4 * r32;
            *(unsigned*)(SG8 + rowoff) = cvt4_fp8((o[0][r] + bb[r]) * bflo(uu[r].x), (o[1][r] + bb[r]) * bfhi(uu[r].x), (o[2][r] + bb[r]) * bflo(uu[r].y), (o[3][r] + bb[r]) * bfhi(uu[r].y)); }
    }
#undef SP_LOAD
    __syncthreads();
}

__device__ __forceinline__ att::BlockRef attn_ref(const Args& a, int item, int pass) {
    const int bh = item >> 2, x = item & 3, b = bh >> 4, h = bh & 15, qb = pass ? 7 - x : x;
    att::BlockRef r; const size_t base = (size_t)(b * SEQ) * D + h * 128;
    r.Q = (const bf16*)(a.ws + WS_Q) + base + (size_t)(qb * 256) * D; r.O = (bf16*)((unsigned char*)(a.ws + WS_OA) + base + (size_t)(qb * 256) * D);
    r.K = (const bf16*)(a.ws + WS_KH) + base; r.V = (const bf16*)(a.ws + WS_VH) + base;
    r.M = (const unsigned*)(a.ws + WS_MASK) + (size_t)(b * SEQ + qb * 256) * 64; r.P0 = qb * 256;
    return r;
}
__device__ __forceinline__ void attn_phase(const Frame& F, const Args& a) {
    constexpr int NITEMS = NB * 16 * 4;
    int L = F.vcu; if (L >= NITEMS) return;
    int pass = 0; att::BlockRef cur = attn_ref(a, L, 0); att::Seam S;
    att::attn_prime(cur, (char*)F.lds, S);
    for (;;) {
        const bool more_pass = pass == 0, more_item = L + F.G < NITEMS, last = !more_pass && !more_item;
        int Ln = L, passn = pass + 1; if (!more_pass) { passn = 0; Ln = more_item ? L + F.G : L; }
        const att::BlockRef nxt = last ? cur : attn_ref(a, Ln, passn);
        att::attn_block(cur, nxt, (char*)F.lds, S);
        if (last) break;
        cur = nxt; L = Ln; pass = passn;
    }
    VM_WAIT(); __syncthreads();
}

__device__ __forceinline__ void router_unit(const Frame& F, const Args& a, int unit) {
    const int b = unit / 32, row0 = unit * 64, lane = F.lane, wave = F.wave, r32 = lane & 31, hi = lane >> 5, l16 = lane & 15, kg = lane >> 4;
    constexpr int RP = 4112;
    LAS char* hiL = (LAS char*)F.lds; LAS char* loL = hiL + 16 * RP;
    LAS float* part = (LAS float*)F.lds;
    LAS float* logit = (LAS float*)(F.lds + 2 * 16 * RP);
    LAS int* hist = (LAS int*)(F.lds + 2 * 16 * RP + 2048);
    const float* X1 = (const float*)(a.ws + WS_X1); unsigned char* H8 = (unsigned char*)(a.ws + WS_H2F8);
    const bf16* WH = (const bf16*)(a.ws + WS_WRT); const bf16* WL = WH + NE * D;
    f32x4 av[8], sv[8];
    { const float* mf = (const float*)(a.ws + WS_MODF) + (size_t)b * (6 * D); const float* gn = a.in[I_N2G];
#pragma unroll
      for (int j = 0; j < 8; ++j) { const int k = 4 * (lane + 64 * j); const f32x4 g4 = *(const f32x4*)(gn + k), sc = *(const f32x4*)(mf + 4 * D + k); sv[j] = *(const f32x4*)(mf + 3 * D + k); av[j] = g4 * (sc + 1.0f); } }
    const float br = a.in[I_BR][F.tid & 31];
    if (F.tid < NE) hist[F.tid] = 0;
#pragma unroll 1
    for (int grp = 0; grp < 4; ++grp) {
        { f32x4 v[2][8]; float ss[2] = {0.f, 0.f};
#pragma unroll
          for (int q = 0; q < 2; ++q) { const f32x4* xr = (const f32x4*)(X1 + (size_t)(row0 + 16 * grp + 2 * wave + q) * D) + lane;
#pragma unroll
              for (int j = 0; j < 8; ++j) v[q][j] = xr[64 * j]; }
#pragma unroll
          for (int q = 0; q < 2; ++q)
#pragma unroll
              for (int j = 0; j < 8; ++j) ss[q] += (v[q][j][0] * v[q][j][0] + v[q][j][1] * v[q][j][1]) + (v[q][j][2] * v[q][j][2] + v[q][j][3] * v[q][j][3]);
#pragma unroll
          for (int q = 0; q < 2; ++q) { const int rl = 2 * wave + q; const size_t row = (size_t)(row0 + 16 * grp + rl);
              const float rstd = 1.0f / sqrtf(wave_sum(ss[q]) * (1.0f / D) + EPS);
#pragma unroll
              for (int j = 0; j < 8; ++j) { const f32x4 y = (v[q][j] * rstd) * av[j] + sv[j];
                  ((unsigned*)(H8 + row * D))[lane + 64 * j] = cvt4_fp8(y[0], y[1], y[2], y[3]);
                  u32x2 w; w.x = cvtpk(y[0], y[1]); w.y = cvtpk(y[2], y[3]);
                  u32x2 l; l.x = cvtpk(y[0] - bflo(w.x), y[1] - bfhi(w.x)); l.y = cvtpk(y[2] - bflo(w.y), y[3] - bfhi(w.y));
                  *(LAS u32x2*)(hiL + rl * RP + (lane + 64 * j) * 8) = w; *(LAS u32x2*)(loL + rl * RP + (lane + 64 * j) * 8) = l; } } }
        LDS_BARRIER();
        f32x4 acc[2] = {{0.f, 0.f, 0.f, 0.f}, {0.f, 0.f, 0.f, 0.f}};
#pragma unroll 1
        for (int kb = 0; kb < 2; ++kb) { bf16x8 bh[4][2], bl[4][2];
#pragma unroll
            for (int ks = 0; ks < 4; ++ks)
#pragma unroll
                for (int nt = 0; nt < 2; ++nt) { const size_t o = (size_t)(l16 + 16 * nt) * D + 256 * wave + 32 * (4 * kb + ks) + 8 * kg; bh[ks][nt] = *(const bf16x8*)(WH + o); bl[ks][nt] = *(const bf16x8*)(WL + o); }
#pragma unroll
            for (int ks = 0; ks < 4; ++ks) { const int ko = (256 * wave + 32 * (4 * kb + ks) + 8 * kg) * 2;
                const bf16x8 ah = *(const LAS bf16x8*)(hiL + l16 * RP + ko), al = *(const LAS bf16x8*)(loL + l16 * RP + ko);
#pragma unroll
                for (int nt = 0; nt < 2; ++nt) { acc[nt] = __builtin_amdgcn_mfma_f32_16x16x32_bf16(ah, bh[ks][nt], acc[nt], 0, 0, 0);
                    acc[nt] = __builtin_amdgcn_mfma_f32_16x16x32_bf16(ah, bl[ks][nt], acc[nt], 0, 0, 0);
                    acc[nt] = __builtin_amdgcn_mfma_f32_16x16x32_bf16(al, bh[ks][nt], acc[nt], 0, 0, 0); } } }
        LDS_BARRIER();
#pragma unroll
        for (int nt = 0; nt < 2; ++nt)
#pragma unroll
            for (int j = 0; j < 4; ++j) part[(wave * 16 + 4 * kg + j) * 32 + 16 * nt + l16] = acc[nt][j];
        LDS_BARRIER();
        { const int rr = F.tid >> 5, e = F.tid & 31; float sum = br;
#pragma unroll
          for (int wv = 0; wv < 8; ++wv) sum += part[(wv * 16 + rr) * 32 + e];
          logit[rr * 32 + e] = sum; }
        LDS_BARRIER();
        { const int rl = 2 * wave + hi, t = row0 + 16 * grp + rl; float v = logit[rl * 32 + r32]; int ei[4]; float ev[4];
#pragma unroll
          for (int k = 0; k < 4; ++k) { float m = v;
#pragma unroll
              for (int o = 1; o < 32; o <<= 1) m = fmaxf(m, __shfl_xor(m, o));
              const unsigned long long bal = __ballot(v == m); const unsigned mine = hi ? (unsigned)(bal >> 32) : (unsigned)bal; const int bi = __ffs(mine) - 1;
              ei[k] = bi; ev[k] = m; if (r32 == bi) v = -__builtin_inff(); }
          if (r32 == 0) { float ex[4], sum = 0.f;
#pragma unroll
              for (int k = 0; k < 4; ++k) { ex[k] = __expf(ev[k] - ev[0]); sum += ex[k]; }
              int* TE = (int*)(a.ws + WS_ROUTE + RT_TOPE) + (size_t)t * 4; float* TG = (float*)(a.ws + WS_ROUTE + RT_TOPG) + (size_t)t * 4; const float inv = 1.0f / sum;
              *(int4*)TE = make_int4(ei[0], ei[1], ei[2], ei[3]); *(f32x4*)TG = (f32x4){ex[0] * inv, ex[1] * inv, ex[2] * inv, ex[3] * inv};
#pragma unroll
              for (int k = 0; k < 4; ++k) atomicAdd((int*)&hist[ei[k]], 1); } }
    }
    __syncthreads();
    if (F.tid < NE) ((int*)(a.ws + WS_ROUTE + RT_HIST))[unit * NE + F.tid] = hist[F.tid];
    __syncthreads();
}

__device__ __forceinline__ void route_unit(const Frame& F, const Args& a, int unit) {
    const int* HIST = (const int*)(a.ws + WS_ROUTE + RT_HIST); const int* TE = (const int*)(a.ws + WS_ROUTE + RT_TOPE) + (size_t)unit * 256; const float* TG = (const float*)(a.ws + WS_ROUTE + RT_TOPG) + (size_t)unit * 256;
    int* POS = (int*)(a.ws + WS_ROUTE + RT_POS) + (size_t)unit * 256; float* RG = (float*)(a.ws + WS_ROUTE + RT_GATE);
    LAS int* cnt = (LAS int*)F.lds; LAS int* before = cnt + 32; LAS int* pstart = cnt + 64; LAS int* te = cnt + 128; LAS int* posl = cnt + 384;
    { LAS int* hl = cnt + 1024;
      { int hv[16];
#pragma unroll
        for (int q = 0; q < 16; ++q) hv[q] = HIST[F.tid + q * (NWAVES * 64)];
#pragma unroll
        for (int q = 0; q < 16; ++q) hl[F.tid + q * (NWAVES * 64)] = hv[q]; }
      __syncthreads();
      if (F.tid < NE) { int c = 0, bf = 0; for (int u2 = 0; u2 < T / 64; ++u2) { const int h = hl[u2 * NE + F.tid]; c += h; if (u2 < unit) bf += h; } cnt[F.tid] = c; before[F.tid] = bf; } }
    if (F.tid < 256) te[F.tid] = TE[F.tid];
    __syncthreads();
    if (F.tid == 0) { int run = 0; for (int e = 0; e < NE; ++e) { pstart[e] = run; run += ((cnt[e] + 255) >> 8) << 8; }
        if (unit == 0) { int* TILE = (int*)(a.ws + WS_ROUTE + RT_TILE); int mt = 0; for (int e = 0; e < NE; ++e) { const int ntile = (cnt[e] + 255) >> 8; for (int q = 0; q < ntile; ++q) TILE[mt++] = e; }
            *(int*)(a.ws + WS_ROUTE + RT_NMT) = mt; } }
    __syncthreads();
    if (F.tid < NE) { int run = pstart[F.tid] + before[F.tid]; for (int sl = 0; sl < 256; ++sl) if (te[sl] == F.tid) posl[sl] = run++; }
    __syncthreads();
    if (F.tid < 256) { const int p = posl[F.tid]; POS[F.tid] = p; RG[p] = TG[F.tid]; ((int*)(a.ws + WS_ROUTE + RT_TOK))[p] = unit * 64 + (F.tid >> 2); }
    __syncthreads();
}

template <bool MOE>
__device__ __forceinline__ void final_rows(const Frame& F, const Args& a, int gw, int NGW) {
    const float* X1 = (const float*)(a.ws + WS_X1); const int* POS = (const int*)(a.ws + WS_ROUTE + RT_POS); const bf16* YS = (const bf16*)(a.ws + WS_YS);
    f32x4 fg[8];
#pragma unroll
    for (int j = 0; j < 8; ++j) fg[j] = ((const f32x4*)a.in[I_FG])[F.lane + 64 * j];
    int row = gw; if (row >= T) return;
    f32x4 v[8]; int4 pos = make_int4(0, 0, 0, 0);
#pragma unroll
    for (int j = 0; j < 8; ++j) v[j] = ((const f32x4*)(X1 + (size_t)row * D))[F.lane + 64 * j];
    if (MOE) pos = *(const int4*)(POS + (size_t)row * 4);
    for (; row < T; row += NGW) {
        f32x4 m[8];
#pragma unroll
        for (int j = 0; j < 8; ++j) m[j] = (f32x4){0.f, 0.f, 0.f, 0.f};
        f32x4 g2[8];
        if (MOE) {
            const int pk[4] = {__builtin_amdgcn_readfirstlane(pos.x), __builtin_amdgcn_readfirstlane(pos.y), __builtin_amdgcn_readfirstlane(pos.z), __builtin_amdgcn_readfirstlane(pos.w)};
            u32x2 ys[4][8];
#pragma unroll
            for (int k = 0; k < 4; ++k)
#pragma unroll
                for (int j = 0; j < 8; ++j) ys[k][j] = ((const u32x2*)(YS + (size_t)pk[k] * D))[F.lane + 64 * j];
#pragma unroll
            for (int j = 0; j < 8; ++j) g2[j] = ((const f32x4*)((const float*)(a.ws + WS_MODF) + (size_t)(row / SEQ) * (6 * D) + 5 * D))[F.lane + 64 * j];
#pragma unroll
            for (int k = 0; k < 4; ++k)
#pragma unroll
                for (int j = 0; j < 8; ++j) { const u32x2 w = ys[k][j]; m[j] += (f32x4){bflo(w.x), bfhi(w.x), bflo(w.y), bfhi(w.y)}; }
        }
        const int nrow = row + NGW; f32x4 vn[8]; int4 posn = pos;
        if (nrow < T) {
#pragma unroll
            for (int j = 0; j < 8; ++j) vn[j] = ((const f32x4*)(X1 + (size_t)nrow * D))[F.lane + 64 * j];
            if (MOE) posn = *(const int4*)(POS + (size_t)nrow * 4); }
        if (MOE) {
#pragma unroll
            for (int j = 0; j < 8; ++j) v[j] += g2[j] * m[j]; }
        float ss = 0.f;
#pragma unroll
        for (int j = 0; j < 8; ++j) ss += (v[j][0] * v[j][0] + v[j][1] * v[j][1]) + (v[j][2] * v[j][2] + v[j][3] * v[j][3]);
        const float rstd = 1.0f / sqrtf(wave_sum(ss) * (1.0f / D) + EPS);
        f32x4* o = (f32x4*)(a.out + (size_t)row * D) + F.lane;
#pragma unroll
        for (int j = 0; j < 8; ++j) o[64 * j] = v[j] * rstd * fg[j];
        if (nrow < T) {
#pragma unroll
            for (int j = 0; j < 8; ++j) v[j] = vn[j];
            pos = posn; }
    }
}

constexpr int N_PHASES = 13;
constexpr int N_LAUNCHES = MK_N_LAUNCHES;

__global__ void __launch_bounds__(NWAVES * 64, 2) fwd_kernel(Args args) {
    extern __shared__ __attribute__((aligned(16))) unsigned char lds_raw[];
    Frame F;
    F.lds = (LAS unsigned char*)lds_raw;
    F.tid = threadIdx.x; F.lane = F.tid & 63; F.wave = __builtin_amdgcn_readfirstlane(F.tid >> 6);
    F.G = gridDim.x; { const int bx = blockIdx.x; F.vcu = (F.G % 8 == 0) ? (bx % 8) * (F.G / 8) + bx / 8 : bx; }
    volatile LAS unsigned* MISC = (volatile LAS unsigned*)(F.lds + MISC_OFF);
    for (int u = F.tid; u < (LDS_BYTES - LDSCTL_OFF) / 4; u += NWAVES * 64) ((LAS unsigned*)(F.lds + LDSCTL_OFF))[u] = 0u;
    __syncthreads();
    unsigned char* ws = args.ws;
    unsigned* barw = (unsigned*)(ws + WS_CTL) + CW_BAR;
    XcdBarrier bar; bar.bar = barw; bar.x = 0; bar.st = nullptr;
    if (N_LAUNCHES == 1) bar = xcd_barrier_post(barw, MISC + 8);
    const int lo = args.ph_lo, hi = args.ph_hi;
#ifndef PH_MASK
#define PH_MASK 0xffff
#endif
#define IN(k) (((PH_MASK >> (k)) & 1) && lo <= (k) && (k) < hi)
#define SEAM(k) do { if (IN(k) && IN((k) + 1)) xcd_barrier(bar); } while (0)
    const int gw = F.vcu * NWAVES + F.wave, NGW = F.G * NWAVES;
    const int NUNIT64 = T / 64;

    if (IN(0)) { p0_prologue(F, args); }

    SEAM(0);
    if (IN(1)) {
        for (int u = F.vcu; u < NUNIT64; u += F.G) norm_mod_rows_unit<false>(F, args, u, args.in[I_X], args.in[I_N1G], 1 * D, 0 * D, nullptr, nullptr, nullptr, (unsigned char*)(ws + WS_H1F8));
        { const float* MODP = (const float*)(ws + WS_MODP); float* MODF = (float*)(ws + WS_MODF); const float* bm = args.in[I_BMOD];
          for (int i = F.vcu * (NWAVES * 64) + F.tid; i < NB * 6 * D; i += F.G * NWAVES * 64) { const int b = i / (6 * D), n = i % (6 * D); float s = bm[n];
#pragma unroll
              for (int kc = 0; kc < KC; ++kc) s += MODP[((size_t)kc * NB + b) * (6 * D) + n];
              MODF[i] = s; } }
    }

    SEAM(1);
    if (IN(2)) {
        { pg8::Gemm g{(const bf16*)(ws + WS_H1F8), (const bf16*)(ws + WS_WIN8), D}; pg8::UnevenOrder S; S.init(T, NIN_B, F.G, (int)blockIdx.x);
          pg8::EpiG1b E{ws};
          pg8::gemm_phase<pg8::EpiG1b, pg8::UnevenOrder, true>(F.lds, g, S, E); }
        pg8::Gemm g{(const bf16*)(ws + WS_H1F8), (const bf16*)(ws + WS_WIN), D}; pg8::StaticOrder S; S.init(T, NIN_A, F.G, (int)blockIdx.x);
        pg8::EpiG1 E{(bf16*)(ws + WS_QI), (bf16*)(ws + WS_KI), (float*)(ws + WS_WI)};
        pg8::gemm_phase<pg8::EpiG1, pg8::StaticOrder, true>(F.lds, g, S, E);
    }

    SEAM(2);
    if (IN(3)) {
        { pg8::Gemm g{(const bf16*)(ws + WS_CKV), (const bf16*)(ws + WS_WKV), 256}; pg8::StaticOrder S; S.init(T, 4096, F.G, (int)blockIdx.x);
          pg8::EpiKV E{(bf16*)(ws + WS_KH), (bf16*)(ws + WS_VH), (const float*)(ws + WS_SSQ)};
          pg8::gemm_phase<pg8::EpiKV, pg8::StaticOrder>(F.lds, g, S, E); }

        for (int it = F.vcu; it < 256; it += F.G) { const int b = it >> 5, x = it & 31;
#pragma unroll 1
            for (int pass = 0; pass < 2; ++pass) { const int qt = pass ? 63 - x : x;
                idx_scores_unit(F, args, b, qt);
                for (int q = 0; q < 4; ++q) topk_mask_row(F, args, b * SEQ + qt * 32 + 4 * F.wave + q);
                } }

        for (int u = F.vcu; u < NB * 16 * 2; u += F.G) spatial_group(F, args, u >> 5, (u >> 1) & 15, u & 1);

    }
    SEAM(4);
    if (IN(5)) {
        const bool conv_first = (blockIdx.x & 1) == 0;
        if (conv_first) moe_conv(F, args);
#ifndef NO_ATTN
        attn_phase(F, args);
#endif

#ifndef NO_YB
        { pg8::Gemm g{(const bf16*)(ws + WS_SG), (const bf16*)(ws + WS_WPB), D}; pg8::StaticOrder S; S.init(T, D, F.G, (int)blockIdx.x);
          pg8::EpiGate<false> E{(const bf16*)(ws + WS_GB), nullptr, (void*)(ws + WS_YB)};
          pg8::gemm_phase<pg8::EpiGate<false>, pg8::StaticOrder, true>(F.lds, g, S, E); }
#endif
        if (!conv_first) { __syncthreads(); moe_conv(F, args); }

    }
    SEAM(5);
    if (IN(6)) {
        pg8::Gemm g{(const bf16*)(ws + WS_OA), (const bf16*)(ws + WS_WPA), D}; pg8::StaticOrder S; S.init(T, D, F.G, (int)blockIdx.x);
        pg8::EpiGate<true> E{(const bf16*)(ws + WS_GA), (const bf16*)(ws + WS_YB), (void*)(ws + WS_MIX)};
        pg8::gemm_phase<pg8::EpiGate<true>, pg8::StaticOrder, true>(F.lds, g, S, E);
    }

    SEAM(6);
    if (IN(7)) {
        pg8::Gemm g{(const bf16*)(ws + WS_MIX), (const bf16*)(ws + WS_WOUT), D}; pg8::StaticOrder S; S.init(T, D, F.G, (int)blockIdx.x);
        pg8::EpiX1 E{args.in[I_X], (const float*)(ws + WS_MODF), (float*)(ws + WS_X1)};
        pg8::gemm_phase<pg8::EpiX1, pg8::StaticOrder, true>(F.lds, g, S, E);
    }

    SEAM(7);
    if (IN(8)) { { int* rt = (int*)(ws + WS_ROUTE + RT_TOK); for (int i = F.vcu * (NWAVES * 64) + F.tid; i < PMAX; i += F.G * NWAVES * 64) rt[i] = 0; }
        for (int u = F.vcu; u < NUNIT64; u += F.G) router_unit(F, args, u); }

    SEAM(8);
    if (IN(9)) { for (int u = F.vcu; u < NUNIT64; u += F.G) route_unit(F, args, u); }

    SEAM(9);
    if (IN(10)) {
        const int nmt = __builtin_amdgcn_readfirstlane(*(const int*)(ws + WS_ROUTE + RT_NMT));
        LAS int* tile_lds = (LAS int*)(F.lds + LDSCTL_OFF + 1024);
        if (F.tid < MT_MAX) tile_lds[F.tid] = ((const int*)(ws + WS_ROUTE + RT_TILE))[F.tid < nmt ? F.tid : 0];
        __syncthreads();
        pg8::Gemm g{(const bf16*)(ws + WS_H2F8), (const bf16*)(ws + WS_WGU), D}; pg8::MoeGatherOrder S; S.init(nmt, 16, F.G, (int)blockIdx.x, tile_lds); S.rowtok = (const int*)(ws + WS_ROUTE + RT_TOK);
        pg8::EpiUp E{args.in[I_BGU], (unsigned char*)(ws + WS_ACT)};
        pg8::gemm_phase<pg8::EpiUp, pg8::MoeGatherOrder, true>(F.lds, g, S, E);
    }

    SEAM(10);
    if (IN(11)) {
        const int nmt = __builtin_amdgcn_readfirstlane(*(const int*)(ws + WS_ROUTE + RT_NMT));
        LAS int* tile_lds = (LAS int*)(F.lds + LDSCTL_OFF + 1024);
        if (F.tid < MT_MAX) tile_lds[F.tid] = ((const int*)(ws + WS_ROUTE + RT_TILE))[F.tid < nmt ? F.tid : 0];
        __syncthreads();
        pg8::Gemm g{(const bf16*)(ws + WS_ACT), (const bf16*)(ws + WS_WD), DFF}; pg8::MoeOrder S; S.init(nmt, 8, F.G, (int)blockIdx.x, tile_lds);
        pg8::EpiDown E{args.in[I_BD], (const float*)(ws + WS_ROUTE + RT_GATE), (bf16*)(ws + WS_YS)};
        pg8::gemm_phase<pg8::EpiDown, pg8::MoeOrder, true>(F.lds, g, S, E);
    }

    SEAM(11);
    if (IN(12)) { final_rows<(MK_STAGE >= 9)>(F, args, gw, NGW); }

#undef IN
#undef SEAM
}

extern "C" void kernel_launch(void* const* d_in, const int* in_sizes, int n_in, void* d_out, int out_size, void* d_ws, size_t ws_size, hipStream_t stream) {
    static int grid = 0;
    if (grid == 0) {
        if (n_in != 23 || out_size != T * D || ws_size < WS_END) { fprintf(stderr, "kernel_launch: unexpected shapes (n_in %d, out %d, ws %zu < %zu)\n", n_in, out_size, ws_size, (size_t)WS_END); grid = -1; return; }
        int dev = 0, cus = 0, per_cu = 0;
        if (hipGetDevice(&dev) != hipSuccess || hipDeviceGetAttribute(&cus, hipDeviceAttributeMultiprocessorCount, dev) != hipSuccess) { grid = -1; return; }
        if (hipFuncSetAttribute((const void*)fwd_kernel, hipFuncAttributeMaxDynamicSharedMemorySize, LDS_BYTES) != hipSuccess) { fprintf(stderr, "kernel_launch: hipFuncSetAttribute failed\n"); grid = -1; return; }
        if (hipOccupancyMaxActiveBlocksPerMultiprocessor(&per_cu, (const void*)fwd_kernel, NWAVES * 64, LDS_BYTES) != hipSuccess || per_cu < 1) { fprintf(stderr, "kernel_launch: occupancy query says %d\n", per_cu); }
        (void)hipGetLastError();
        grid = cus;
    }
    if (grid < 0) return;
    (void)hipMemsetAsync((char*)d_ws + WS_CTL, 0, CTL_ZERO_BYTES, stream);
    Args a{};
    for (int i = 0; i < 23; ++i) a.in[i] = (const float*)d_in[i];
    a.out = (float*)d_out; a.ws = (unsigned char*)d_ws;
    if (N_LAUNCHES == 1) { a.ph_lo = 0; a.ph_hi = N_PHASES; hipLaunchKernelGGL(fwd_kernel, dim3(grid), dim3(NWAVES * 64), LDS_BYTES, stream, a); }
    else { for (int p = 0; p < N_PHASES; ++p) {
#if MK_STAGE < 9
        if (p >= 8 && p < 12) continue;
#endif
        a.ph_lo = p; a.ph_hi = p + 1; hipLaunchKernelGGL(fwd_kernel, dim3(grid), dim3(NWAVES * 64), LDS_BYTES, stream, a); } }
}
```

```cpp
#include <hip/hip_runtime.h>
#include <cstdio>
#include <cstdint>

#ifndef MK_N_LAUNCHES
#define MK_N_LAUNCHES 1
#endif
#ifndef MK_STAGE
#define MK_STAGE 9
#endif

#define GAS __attribute__((address_space(1)))
#define LAS __attribute__((address_space(3)))
typedef unsigned short bf16;
typedef short bf16x8 __attribute__((ext_vector_type(8)));
typedef short s16x4 __attribute__((ext_vector_type(4)));
typedef float f32x2 __attribute__((ext_vector_type(2)));
typedef float f32x4 __attribute__((ext_vector_type(4)));
typedef float f32x16 __attribute__((ext_vector_type(16)));
typedef unsigned u32x2 __attribute__((ext_vector_type(2)));
typedef unsigned u32x4 __attribute__((ext_vector_type(4)));
typedef GAS unsigned gu32;
typedef int i32x8 __attribute__((ext_vector_type(8)));
constexpr float W8_SCALE = 32.0f, W8_INV = 1.0f / 32.0f;
__device__ __forceinline__ unsigned cvt4_fp8(float a, float b, float c, float d) { int w = 0; w = __builtin_amdgcn_cvt_pk_fp8_f32(a, b, w, false); w = __builtin_amdgcn_cvt_pk_fp8_f32(c, d, w, true); return (unsigned)w; }
#define RLX_AGENT __ATOMIC_RELAXED, __HIP_MEMORY_SCOPE_AGENT
#define LDS_WAIT() asm volatile("s_waitcnt lgkmcnt(0)" ::: "memory")
#define VM_WAIT() asm volatile("s_waitcnt vmcnt(0)" ::: "memory")
#define LDS_BARRIER() do { asm volatile("s_waitcnt lgkmcnt(0)" ::: "memory"); __builtin_amdgcn_s_barrier(); asm volatile("" ::: "memory"); } while (0)

constexpr int D = 2048, NB = 8, SEQ = 2048, T = NB * SEQ;
constexpr int NIN_SRC = 12688, NIN = 12800;
constexpr int NIN_A = 2304, NIN_B = 10496;
constexpr int NE = 32, TOPK = 4, DFF = 2048;
constexpr int PMAX = T * TOPK + NE * 256;
constexpr int MT_MAX = PMAX / 256;
constexpr int KC = 8;
constexpr float EPS = 1e-6f;
constexpr float IDX_W_SCALE = 0.25f * 0.08838834764831845f;
constexpr int KSEL = 256;

constexpr size_t MiB = 1u << 20;
constexpr size_t WS_CTL = 0, CTL_ZERO_BYTES = 1 * MiB;
constexpr size_t WS_MODP = 1 * MiB;
constexpr size_t WS_MODF = 13 * MiB;
constexpr size_t WS_WKV = 14 * MiB;
constexpr size_t WS_WSP = 16 * MiB;
constexpr size_t WS_WRT = 17 * MiB;
constexpr size_t WS_SSQ = 18 * MiB;
constexpr size_t WS_WI = 19 * MiB;
constexpr size_t WS_KI = 20 * MiB;
constexpr size_t WS_MASK = 24 * MiB;
constexpr size_t WS_ROUTE = 28 * MiB;
constexpr size_t WS_CKV = 30 * MiB;
constexpr size_t WS_WPA = 40 * MiB, WS_WPB = 48 * MiB, WS_WOUT = 56 * MiB;
constexpr size_t WS_WIN = 64 * MiB;
constexpr size_t WS_WIN8 = 96 * MiB;
constexpr size_t WS_H2F8 = 2176 * MiB;
constexpr size_t WS_H1F8 = 2176 * MiB;
constexpr size_t WS_H1 = 128 * MiB;
constexpr size_t WS_Q = 192 * MiB, WS_QI = 256 * MiB, WS_U = 320 * MiB, WS_V = 384 * MiB, WS_GA = 448 * MiB, WS_GB = 512 * MiB;
constexpr size_t WS_KH = 576 * MiB, WS_VH = 640 * MiB, WS_VST = 704 * MiB  , WS_SG = 768 * MiB, WS_OA = 832 * MiB, WS_YB = 896 * MiB, WS_MIX = 960 * MiB;
constexpr size_t WS_H2 = 1024 * MiB, WS_H2LO = 1088 * MiB;
constexpr size_t WS_SC = 1152 * MiB;
constexpr size_t WS_X1 = 1280 * MiB;
constexpr size_t WS_WGU = 1408 * MiB;
constexpr size_t WS_WD = 1920 * MiB;
constexpr size_t WS_XG = 2176 * MiB, WS_ACT = 2464 * MiB, WS_YS = 2752 * MiB;
constexpr size_t WS_END = 3040 * MiB;
constexpr size_t RT_TOPE = 0, RT_TOPG = 256 * 1024, RT_POS = 512 * 1024, RT_HIST = 768 * 1024, RT_TILE = 832 * 1024, RT_NMT = 896 * 1024, RT_GATE = 1024 * 1024, RT_TOK = 1536 * 1024;
constexpr int CW_BAR = 4096;

constexpr int RING_BYTES = 147456;
constexpr int LDSCTL_OFF = RING_BYTES, MISC_OFF = LDSCTL_OFF + 320;
constexpr int LDS_BYTES = 155648;
constexpr int NWAVES = 8;

__device__ __forceinline__ unsigned cvtpk(float lo, float hi) { unsigned r; asm volatile("v_cvt_pk_bf16_f32 %0, %1, %2" : "=v"(r) : "v"(lo), "v"(hi)); return r; }
__device__ __forceinline__ void gload_x4_untracked(f32x4& dst, const float* p) { asm volatile("global_load_dwordx4 %0, %1, off" : "=v"(dst) : "v"(p) : "memory"); }
__device__ __forceinline__ void gload_x1_untracked(float& dst, const float* p) { asm volatile("global_load_dword %0, %1, off" : "=v"(dst) : "v"(p) : "memory"); }
__device__ __forceinline__ float bf2f(unsigned short h) { return __builtin_bit_cast(float, (unsigned)h << 16); }
__device__ __forceinline__ float bflo(unsigned w) { return __builtin_bit_cast(float, w << 16); }
__device__ __forceinline__ float bfhi(unsigned w) { return __builtin_bit_cast(float, w & 0xffff0000u); }
__device__ __forceinline__ float wave_sum(float v) {
#pragma unroll
    for (int o = 1; o < 64; o <<= 1) v += __shfl_xor(v, o);
    return v;
}
__device__ __forceinline__ float sigmoidf_(float x) { return __builtin_amdgcn_rcpf(1.0f + __builtin_amdgcn_exp2f(-1.4426950408889634f * x)); }
__device__ __forceinline__ f32x2 gelu_pk(f32x2 v) {
    const f32x2 av = __builtin_elementwise_abs(v), d = av * 0.2316418882f + 1.0f;
    f32x2 t; t.x = __builtin_amdgcn_rcpf(d.x); t.y = __builtin_amdgcn_rcpf(d.y);
    f32x2 q = t * 0.5307027145f + (-0.7265760135f); q = q * t + 0.7107068705f; q = q * t + (-0.142248368f); q = q * t + 0.127414796f; q = q * t;
    const f32x2 s = (v * v) * (-0.72134752044f);
    f32x2 e; e.x = __builtin_amdgcn_exp2f(s.x); e.y = __builtin_amdgcn_exp2f(s.y);
    const f32x2 m = v * (q * e), r = v - m;
    f32x2 o; o.x = v.x < 0.f ? m.x : r.x; o.y = v.y < 0.f ? m.y : r.y; return o;
}

namespace pg8 {
constexpr int BM = 256, BK = 64, HALF = 128, HTB = HALF * BK * 2, STAGE_BYTES = 8 * HTB, NXCD = 8, WGM = 4;
__host__ __device__ __forceinline__ int lds_byte(int r, int c) { const int st = (r >> 4) * 2 + (c >> 5), rr = r & 15, cc = c & 31, ob = rr * 64 + cc * 2; return st * 1024 + (ob ^ (((ob >> 9) & 1) << 5)); }
__host__ __device__ __forceinline__ void stage_rc(int b, int& R, int& C) { const int st = b / 1024, sb = b % 1024, swz = sb ^ (((sb >> 9) & 1) << 5); R = (st >> 1) * 16 + swz / 64; C = (st & 1) * 32 + (swz % 64) / 2; }
__host__ __device__ __forceinline__ int perm32(int rho) { const int n = rho >> 4, i = rho & 15; return 8 * (i >> 2) + 4 * n + (i & 3); }

struct Unit { int pm, pn, pb, e; };
struct Gemm { const bf16* A; const bf16* Bt; int K; };
template <class S, class = void> struct SchedGather { static constexpr bool v = false; };
template <class S> struct SchedGather<S, decltype((void)S::GATHER)> { static constexpr bool v = S::GATHER; };

struct StaticOrder {
    int nM, nN, nwg, G, c;
    __device__ void init(int M, int N, int G_, int c_) { nM = M / BM; nN = N / BM; nwg = nM * nN; G = G_; c = c_; }
    __device__ bool next(int i, Unit& u) const {
        const long L = (long)i * G + c; if (L >= nwg) return false;
        int wgid = (int)L; { const int q = nwg / NXCD, r = nwg % NXCD, xcd = wgid % NXCD, off = wgid / NXCD; wgid = (xcd < r ? xcd * (q + 1) : r * (q + 1) + (xcd - r) * q) + off; }
        const int nig = WGM * nN, gid = wgid / nig, fm = gid * WGM, gsz = (nM - fm) < WGM ? (nM - fm) : WGM;
        u.pm = fm + ((wgid % nig) % gsz); u.pn = (wgid % nig) / gsz; u.pb = u.pn; u.e = 0; return true;
    }
};
struct UnevenOrder {
    static constexpr int FR = 9, XR = 2, C0 = 64;
    StaticOrder so; bool uneven;
    __device__ void init(int M, int N, int G_, int c_) { so.init(M, N, G_, c_); uneven = (G_ == 256 && so.nwg % NXCD == 0 && so.nwg >= FR * 256 && so.nwg <= FR * 256 + XR * (256 - C0)); }
    __device__ bool next(int i, Unit& u) const {
        if (!uneven) return so.next(i, u);
        long L;
        if (i < FR) L = (long)i * 256 + so.c; else { if (so.c < C0 || i >= FR + XR) return false; L = FR * 256 + (long)(i - FR) * (256 - C0) + (so.c - C0); if (L >= so.nwg) return false; }
        int wgid = (int)L; { const int q = so.nwg / NXCD, xcd = wgid % NXCD, off = wgid / NXCD; wgid = xcd * q + off; }
        const int nig = WGM * so.nN, gid = wgid / nig, fm = gid * WGM, gsz = (so.nM - fm) < WGM ? (so.nM - fm) : WGM;
        u.pm = fm + ((wgid % nig) % gsz); u.pn = (wgid % nig) / gsz; u.pb = u.pn; u.e = 0; return true;
    }
};
struct MoeOrder {
    int nM, nN, nwg, G, c; const LAS int* tile_e;
    __device__ void init(int nM_, int nN_, int G_, int c_, const LAS int* te) { nM = nM_; nN = nN_; nwg = nM * nN; G = G_; c = c_; tile_e = te; }
    __device__ bool next(int i, Unit& u) const {
        const long L = (long)i * G + c; if (L >= nwg) return false;
        int wgid = (int)L; { const int q = nwg / NXCD, r = nwg % NXCD, xcd = wgid % NXCD, off = wgid / NXCD; wgid = (xcd < r ? xcd * (q + 1) : r * (q + 1) + (xcd - r) * q) + off; }
        const int nig = WGM * nN, gid = wgid / nig, fm = gid * WGM, gsz = (nM - fm) < WGM ? (nM - fm) : WGM;
        u.pm = fm + ((wgid % nig) % gsz); u.pn = (wgid % nig) / gsz; u.e = __builtin_amdgcn_readfirstlane(tile_e[u.pm]); u.pb = u.e * nN + u.pn; return true;
    }
};

struct MoeGatherOrder : MoeOrder { static constexpr bool GATHER = true; const int* rowtok; };
template <class Epi, class Sched, bool F8 = false, bool ALIGN_EPI = true>
__device__ __forceinline__ void gemm_phase(LAS unsigned char* lds, const Gemm g, const Sched& S, const Epi& E) {
    const int tid = threadIdx.x, wid = __builtin_amdgcn_readfirstlane(tid >> 6), lane = tid & 63, wr = wid >> 2, wc = wid & 3, fr = lane & 15, fq = lane >> 4;
    const int K = F8 ? g.K / 2 : g.K, nt = K / BK;
    constexpr bool GA = SchedGather<Sched>::v;
    unsigned voffA[2], voffB[2]; int Rr[2]; unsigned cofs[2];
#pragma unroll
    for (int i = 0; i < 2; ++i) { int R, C; stage_rc(tid * 16 + i * 8192, R, C); const int Rb = Epi::PERM ? ((R & ~31) + perm32(R & 31)) : R;
        voffA[i] = (unsigned)(R * K + C) * 2u; voffB[i] = (unsigned)(Rb * K + C) * 2u; Rr[i] = R; cofs[i] = (unsigned)C * 2u; }
    unsigned gC[2][2], gN[2][2]; int tokN[2][2];
    const size_t kstep = (size_t)(BK * 2);
    const size_t hstep = (size_t)HALF * K * 2;
    const size_t tstep = 2 * hstep;
    const unsigned ldsw = (unsigned)wid * 1024u;
    const int aoff = lds_byte(wr * 64 + fr, fq * 8), boff = lds_byte(wc * 32 + fr, fq * 8);
#define PG8_SA(b, h) (((b) * 2 + (h)) * HTB)
#define PG8_SB(b, h) ((4 + (b) * 2 + (h)) * HTB)
#define PG8_STAGE(bufoff, gbase, voff) do { _Pragma("unroll") for (int _i = 0; _i < 2; ++_i) \
        __builtin_amdgcn_global_load_lds((const unsigned*)((const char*)(gbase) + (voff)[_i]), (LAS unsigned*)(lds + (bufoff) + ldsw + _i * 8192), 16, 0, 0); } while (0)
#define PG8_STAGE_A(bufoff, kb, h, NX) do { if constexpr (GA) { _Pragma("unroll") for (int _i = 0; _i < 2; ++_i) { const unsigned vo_ = (NX) ? gN[h][_i] : gC[h][_i]; \
        __builtin_amdgcn_global_load_lds((const unsigned*)((const char*)(kb) + vo_), (LAS unsigned*)(lds + (bufoff) + ldsw + _i * 8192), 16, 0, 0); } } else PG8_STAGE(bufoff, (kb) + ((h) ? hstep : 0), voffA); } while (0)
#define PG8_LD8(p_) ({ const u32x4 lo_ = *(const LAS u32x4*)(p_), hi_ = *(const LAS u32x4*)((p_) + 1024); (i32x8){(int)lo_.x, (int)lo_.y, (int)lo_.z, (int)lo_.w, (int)hi_.x, (int)hi_.y, (int)hi_.z, (int)hi_.w}; })
#define PG8_LDA(dst, b, h) do { if constexpr (F8) { _Pragma("unroll") for (int m = 0; m < 4; ++m) dst##8[m] = PG8_LD8(lds + PG8_SA(b, h) + aoff + m * 2048); } else { \
        _Pragma("unroll") for (int m = 0; m < 4; ++m) _Pragma("unroll") for (int k = 0; k < 2; ++k) dst[m][k] = *(const LAS bf16x8*)(lds + PG8_SA(b, h) + aoff + m * 2048 + k * 1024); } } while (0)
#define PG8_LDB(dst, b, h) do { if constexpr (F8) { _Pragma("unroll") for (int n = 0; n < 2; ++n) dst##8[n] = PG8_LD8(lds + PG8_SB(b, h) + boff + n * 2048); } else { \
        _Pragma("unroll") for (int n = 0; n < 2; ++n) _Pragma("unroll") for (int k = 0; k < 2; ++k) dst[n][k] = *(const LAS bf16x8*)(lds + PG8_SB(b, h) + boff + n * 2048 + k * 1024); } } while (0)
#define PG8_MMA(ai, bj, At, Bt) do { __builtin_amdgcn_s_setprio(1); if constexpr (F8) { _Pragma("unroll") for (int m = 0; m < 4; ++m) _Pragma("unroll") for (int n = 0; n < 2; ++n) \
        asm volatile("v_mfma_f32_16x16x128_f8f6f4 %0, %1, %2, %0" : "+v"(acc[ai][bj][m][n]) : "v"(Bt##8[n]), "v"(At##8[m])); } else { \
        _Pragma("unroll") for (int m = 0; m < 4; ++m) _Pragma("unroll") for (int n = 0; n < 2; ++n) _Pragma("unroll") for (int k = 0; k < 2; ++k) \
        acc[ai][bj][m][n] = __builtin_amdgcn_mfma_f32_16x16x32_bf16(Bt[n][k], At[m][k], acc[ai][bj][m][n], 0, 0, 0); } __builtin_amdgcn_s_setprio(0); } while (0)
#define PG8_WAIT_V(n) asm volatile("s_waitcnt vmcnt(" #n ")" ::: "memory")
#define PG8_WAIT_V8L() do { if (Epi::HAS_PRE && last) asm volatile("s_waitcnt vmcnt(%0)" :: "i"(8 + Epi::NPRE) : "memory"); else asm volatile("s_waitcnt vmcnt(8)" ::: "memory"); } while (0)
#define PG8_WAIT_L(n) asm volatile("s_waitcnt lgkmcnt(" #n ")" ::: "memory")
#define PG8_BAR __builtin_amdgcn_s_barrier()
#define PG8_SCHED __builtin_amdgcn_sched_barrier(0)
    Unit cur, nxt; int ui = 0;
    if (!S.next(0, cur)) return;
    f32x4 acc[2][2][4][2];
#pragma unroll
    for (int a = 0; a < 2; ++a)
#pragma unroll
        for (int b = 0; b < 2; ++b)
#pragma unroll
            for (int m = 0; m < 4; ++m)
#pragma unroll
                for (int n = 0; n < 2; ++n) acc[a][b][m][n] = (f32x4){0.f, 0.f, 0.f, 0.f};
    typename Epi::Pre epre;
    bf16x8 At[4][2], B0[2][2], B1[2][2]; i32x8 At8[4], B08[2], B18[2];
    const char* cA = GA ? (const char*)g.A : (const char*)g.A + (size_t)cur.pm * tstep; const char* cB = (const char*)g.Bt + (size_t)cur.pb * tstep;
    if constexpr (GA) {
#pragma unroll
        for (int h = 0; h < 2; ++h)
#pragma unroll
            for (int i = 0; i < 2; ++i) { gC[h][i] = (unsigned)S.rowtok[cur.pm * BM + h * HALF + Rr[i]] * (unsigned)(K * 2) + cofs[i]; gN[h][i] = gC[h][i]; tokN[h][i] = 0; } }
    PG8_STAGE(PG8_SB(0, 0), cB, voffB); PG8_STAGE(PG8_SB(0, 1), cB + hstep, voffB); PG8_STAGE_A(PG8_SA(0, 0), cA, 0, false); PG8_STAGE_A(PG8_SA(0, 1), cA, 1, false);
    if (wr == 1) PG8_BAR;
    PG8_WAIT_V(2); PG8_BAR;
    PG8_STAGE(PG8_SB(1, 0), cB + kstep, voffB); PG8_STAGE_A(PG8_SA(1, 0), cA + kstep, 0, false); PG8_STAGE(PG8_SB(1, 1), cB + hstep + kstep, voffB);
    PG8_WAIT_V(6); PG8_BAR;
    for (;;) {
        const bool has_next = S.next(ui + 1, nxt);
        const char* nA = GA ? cA : (has_next ? (const char*)g.A + (size_t)nxt.pm * tstep : cA); const char* nB = has_next ? (const char*)g.Bt + (size_t)nxt.pb * tstep : cB;
        if constexpr (GA) { if (has_next) {
#pragma unroll
            for (int h = 0; h < 2; ++h)
#pragma unroll
                for (int i = 0; i < 2; ++i) asm volatile("global_load_dword %0, %1, off" : "=v"(tokN[h][i]) : "v"(S.rowtok + nxt.pm * BM + h * HALF + Rr[i]) : "memory"); } }
        for (int t = 0; t < nt; t += 2) {
            const bool last = (t == nt - 2);
            if constexpr (GA) { if (last && has_next) {
#pragma unroll
                for (int h = 0; h < 2; ++h)
#pragma unroll
                    for (int i = 0; i < 2; ++i) { asm volatile("" : "+v"(tokN[h][i])); gN[h][i] = (unsigned)tokN[h][i] * (unsigned)(K * 2) + cofs[i]; } } }
            if constexpr (Epi::HAS_PRE) { if (last) { int lp_; asm volatile("v_mbcnt_lo_u32_b32 %0, -1, 0\n\tv_mbcnt_hi_u32_b32 %0, -1, %0" : "=v"(lp_)); E.pre(epre, cur, wr, wc, lp_ & 15, lp_ >> 4); } }
            const char* a1 = cA + (size_t)(t + 1) * kstep;
            const char* a2 = last ? nA : cA + (size_t)(t + 2) * kstep; const char* b2 = last ? nB : cB + (size_t)(t + 2) * kstep;
            const char* a3 = a2 + kstep; const char* b3 = b2 + kstep;
            PG8_LDB(B0, 0, 0); PG8_LDB(B1, 0, 1); PG8_SCHED; PG8_LDA(At, 0, 0); PG8_STAGE_A(PG8_SA(1, 1), a1, 1, false);
            PG8_WAIT_V8L(); PG8_WAIT_L(0); PG8_BAR; PG8_MMA(0, 0, At, B0); PG8_MMA(0, 1, At, B1); PG8_BAR; PG8_SCHED;
            PG8_LDA(At, 0, 1); PG8_STAGE(PG8_SB(0, 0), b2, voffB); PG8_STAGE(PG8_SB(0, 1), b2 + hstep, voffB); PG8_STAGE_A(PG8_SA(0, 0), a2, 0, last);
            PG8_WAIT_V8L(); PG8_WAIT_L(0); PG8_BAR; PG8_MMA(1, 0, At, B0); PG8_MMA(1, 1, At, B1); PG8_BAR; PG8_SCHED;
            PG8_LDB(B0, 1, 0); PG8_LDB(B1, 1, 1); PG8_SCHED; PG8_LDA(At, 1, 0); PG8_STAGE_A(PG8_SA(0, 1), a2, 1, last);
            PG8_WAIT_V(8); PG8_WAIT_L(0); PG8_BAR; PG8_MMA(0, 0, At, B0); PG8_MMA(0, 1, At, B1); PG8_BAR; PG8_SCHED;
            PG8_LDA(At, 1, 1); PG8_STAGE(PG8_SB(1, 0), b3, voffB); PG8_STAGE(PG8_SB(1, 1), b3 + hstep, voffB); PG8_STAGE_A(PG8_SA(1, 0), a3, 0, last);
            PG8_WAIT_V(8); PG8_WAIT_L(0); PG8_BAR; PG8_MMA(1, 0, At, B0); PG8_MMA(1, 1, At, B1); PG8_BAR; PG8_SCHED;
        }
        if constexpr (F8) asm volatile("s_nop 15\n\ts_nop 15" ::: "memory");
        if constexpr (ALIGN_EPI) { if (wr == 0) PG8_BAR; }
        { int ln_; asm volatile("v_mbcnt_lo_u32_b32 %0, -1, 0\n\tv_mbcnt_hi_u32_b32 %0, -1, %0" : "=v"(ln_));
          if constexpr (Epi::HAS_PRE) E(acc, cur, wr, wc, ln_ & 15, ln_ >> 4, epre); else E(acc, cur, wr, wc, ln_ & 15, ln_ >> 4); }
        if (!has_next) break;
#pragma unroll
        for (int a = 0; a < 2; ++a)
#pragma unroll
            for (int b = 0; b < 2; ++b)
#pragma unroll
                for (int m = 0; m < 4; ++m)
#pragma unroll
                    for (int n = 0; n < 2; ++n) acc[a][b][m][n] = (f32x4){0.f, 0.f, 0.f, 0.f};
        cur = nxt; cA = nA; cB = nB; ++ui;
        if constexpr (GA) {
#pragma unroll
            for (int h = 0; h < 2; ++h)
#pragma unroll
                for (int i = 0; i < 2; ++i) gC[h][i] = gN[h][i]; }
        if constexpr (ALIGN_EPI) { if (wr == 1) PG8_BAR; }
    }
    PG8_WAIT_V(0);
    if constexpr (!ALIGN_EPI) { if (wr == 0) PG8_BAR; }
    PG8_BAR;
#undef PG8_SA
#undef PG8_SB
#undef PG8_STAGE
#undef PG8_STAGE_A
#undef PG8_LDA
#undef PG8_LD8
#undef PG8_LDB
#undef PG8_MMA
#undef PG8_WAIT_V
#undef PG8_WAIT_V8L
#undef PG8_WAIT_L
#undef PG8_BAR
#undef PG8_SCHED
}

typedef f32x4 Acc[2][2][4][2];
__device__ __forceinline__ u32x4 pack8(const f32x4 a, const f32x4 b) { u32x4 w; w.x = cvtpk(a[0], a[1]); w.y = cvtpk(a[2], a[3]); w.z = cvtpk(b[0], b[1]); w.w = cvtpk(b[2], b[3]); return w; }
__device__ __forceinline__ void unpack8(const u32x4 w, f32x4& a, f32x4& b) { a = (f32x4){bflo(w.x), bfhi(w.x), bflo(w.y), bfhi(w.y)}; b = (f32x4){bflo(w.z), bfhi(w.z), bflo(w.w), bfhi(w.w)}; }

struct EpiG1 {
    static constexpr bool PERM = true; static constexpr bool HAS_PRE = false; static constexpr int NPRE = 0; struct Pre {};
    bf16 *QI, *KI; float* WI;
    __device__ __forceinline__ void operator()(const Acc& acc, const Unit& u, int wr, int wc, int fr, int fq) const {
        const int pn = u.pn, row0 = u.pm * BM + wr * 64 + fr, cw = wc * 32 + 8 * fq;
        if (pn == 8) {
#pragma unroll
            for (int ai = 0; ai < 2; ++ai)
#pragma unroll
                for (int m = 0; m < 4; ++m) { const int row = row0 + ai * HALF + m * 16;
                    *(u32x4*)(KI + (size_t)row * 128 + cw) = pack8(acc[ai][0][m][0] * W8_INV, acc[ai][0][m][1] * W8_INV);
                    if (wc == 0 && fq < 2) { float* wp = WI + (size_t)row * 16 + 8 * fq; *(f32x4*)wp = acc[ai][1][m][0] * (IDX_W_SCALE * W8_INV); *(f32x4*)(wp + 4) = acc[ai][1][m][1] * (IDX_W_SCALE * W8_INV); } }
        } else {
#pragma unroll
            for (int ai = 0; ai < 2; ++ai)
#pragma unroll
                for (int m = 0; m < 4; ++m) { bf16* rowp = QI + (size_t)(row0 + ai * HALF + m * 16) * D + pn * 256 + cw;
#pragma unroll
                    for (int bj = 0; bj < 2; ++bj) *(u32x4*)(rowp + bj * HALF) = pack8(acc[ai][bj][m][0] * W8_INV, acc[ai][bj][m][1] * W8_INV); }
        }
    }
};
struct EpiG1b {
    static constexpr bool PERM = true; static constexpr bool HAS_PRE = false; static constexpr int NPRE = 0; struct Pre {};
    unsigned char* ws;
    __device__ __forceinline__ void operator()(const Acc& acc, const Unit& u, int wr, int wc, int fr, int fq) const {
        const int pn = u.pn, row0 = u.pm * BM + wr * 64 + fr, cw = wc * 32 + 8 * fq;
        bf16* const Q = (bf16*)(ws + WS_Q); bf16* const CKV = (bf16*)(ws + WS_CKV); float* const SSQ = (float*)(ws + WS_SSQ); float* const VST = (float*)(ws + WS_VST);
        if (pn == 8) {
#pragma unroll
            for (int ai = 0; ai < 2; ++ai)
#pragma unroll
                for (int m = 0; m < 4; ++m) { const int row = row0 + ai * HALF + m * 16; bf16* rowp = CKV + (size_t)row * 256 + cw; float sq = 0.f;
#pragma unroll
                    for (int bj = 0; bj < 2; ++bj) { const f32x4 v0 = acc[ai][bj][m][0] * W8_INV, v1 = acc[ai][bj][m][1] * W8_INV;
                        sq += (v0[0] * v0[0] + v0[1] * v0[1]) + (v0[2] * v0[2] + v0[3] * v0[3]) + (v1[0] * v1[0] + v1[1] * v1[1]) + (v1[2] * v1[2] + v1[3] * v1[3]);
                        *(u32x4*)(rowp + bj * HALF) = pack8(v0, v1); }
                    sq += __shfl_xor(sq, 16); sq += __shfl_xor(sq, 32);
                    if (fq == 0) SSQ[(size_t)row * 4 + wc] = sq; }
            return; }
        if (pn < 8) {
#pragma unroll
            for (int ai = 0; ai < 2; ++ai)
#pragma unroll
                for (int m = 0; m < 4; ++m) { bf16* rowp = Q + (size_t)(row0 + ai * HALF + m * 16) * D + pn * 256 + cw;
#pragma unroll
                    for (int bj = 0; bj < 2; ++bj) *(u32x4*)(rowp + bj * HALF) = pack8(acc[ai][bj][m][0] * W8_INV, acc[ai][bj][m][1] * W8_INV); }
            return; }
        const int pz = pn - 9;
        bf16* O = (bf16*)(ws + (pz < 8 ? WS_U : (pz < 16 ? WS_V : (pz < 24 ? WS_GA : WS_GB)))); const int colt = pz & 7; const bool gl = pz < 16, st = (pz >> 3) == 1;
#pragma unroll
        for (int ai = 0; ai < 2; ++ai)
#pragma unroll
            for (int m = 0; m < 4; ++m) { const int row = row0 + ai * HALF + m * 16; bf16* rowp = O + (size_t)row * D + colt * 256 + cw; float s1 = 0.f, s2 = 0.f;
#pragma unroll
                for (int bj = 0; bj < 2; ++bj) { f32x4 v0 = acc[ai][bj][m][0] * W8_INV, v1 = acc[ai][bj][m][1] * W8_INV;
                    if (gl) { const f32x2 a = gelu_pk((f32x2){v0[0], v0[1]}), b = gelu_pk((f32x2){v0[2], v0[3]}), c = gelu_pk((f32x2){v1[0], v1[1]}), d = gelu_pk((f32x2){v1[2], v1[3]});
                        v0 = (f32x4){a.x, a.y, b.x, b.y}; v1 = (f32x4){c.x, c.y, d.x, d.y};
                        s1 += (v0[0] + v0[1]) + (v0[2] + v0[3]) + (v1[0] + v1[1]) + (v1[2] + v1[3]);
                        s2 += (v0[0] * v0[0] + v0[1] * v0[1]) + (v0[2] * v0[2] + v0[3] * v0[3]) + (v1[0] * v1[0] + v1[1] * v1[1]) + (v1[2] * v1[2] + v1[3] * v1[3]); }
                    else {
#pragma unroll
                        for (int e = 0; e < 4; ++e) { v0[e] = sigmoidf_(v0[e]); v1[e] = sigmoidf_(v1[e]); } }
                    *(u32x4*)(rowp + bj * HALF) = pack8(v0, v1); }
                if (st) { s1 += __shfl_xor(s1, 16); s1 += __shfl_xor(s1, 32); s2 += __shfl_xor(s2, 16); s2 += __shfl_xor(s2, 32);
                    if (fq == 0) *(f32x2*)(VST + ((size_t)row * 32 + colt * 4 + wc) * 2) = (f32x2){s1, s2}; } }
    }
};
struct EpiKV {
    static constexpr bool PERM = true; static constexpr bool HAS_PRE = false; static constexpr int NPRE = 0; struct Pre {};
    bf16 *KH, *VH; const float* SSQ;
    __device__ __forceinline__ void operator()(const Acc& acc, const Unit& u, int wr, int wc, int fr, int fq) const {
        const int row0 = u.pm * BM + wr * 64 + fr, cw = wc * 32 + 8 * fq;
        bf16* O = u.pn < 8 ? KH : VH; const int colt = (u.pn & 7) * 256;
        f32x4 sq[2][4];
#pragma unroll
        for (int ai = 0; ai < 2; ++ai)
#pragma unroll
            for (int m = 0; m < 4; ++m) sq[ai][m] = *(const f32x4*)(SSQ + (size_t)(row0 + ai * HALF + m * 16) * 4);
#pragma unroll
        for (int ai = 0; ai < 2; ++ai)
#pragma unroll
            for (int m = 0; m < 4; ++m) { const int row = row0 + ai * HALF + m * 16; const f32x4 q = sq[ai][m];
                const float rstd = 1.0f / sqrtf(((q[0] + q[1]) + (q[2] + q[3])) * (1.0f / 256.0f) + EPS);
                bf16* rowp = O + (size_t)row * D + colt + cw;
#pragma unroll
                for (int bj = 0; bj < 2; ++bj) *(u32x4*)(rowp + bj * HALF) = pack8(acc[ai][bj][m][0] * rstd, acc[ai][bj][m][1] * rstd); }
    }
};
template <bool ADD> struct EpiGate {
    static constexpr bool PERM = true; static constexpr bool HAS_PRE = false; static constexpr int NPRE = 0; struct Pre {};
    const bf16* G; const bf16* Y; void* O;
    __device__ __forceinline__ void operator()(const Acc& acc, const Unit& u, int wr, int wc, int fr, int fq) const {
        const int row0 = u.pm * BM + wr * 64 + fr, col0 = u.pn * BM + wc * 32 + 8 * fq;
#pragma unroll
        for (int ai = 0; ai < 2; ++ai) {
            u32x4 gv[4][2], yv[4][2];
#pragma unroll
            for (int m = 0; m < 4; ++m)
#pragma unroll
                for (int bj = 0; bj < 2; ++bj) { const size_t off = (size_t)(row0 + ai * HALF + m * 16) * D + col0 + bj * HALF; gv[m][bj] = *(const u32x4*)(G + off); if (ADD) yv[m][bj] = *(const u32x4*)(Y + off); }
#pragma unroll
            for (int m = 0; m < 4; ++m)
#pragma unroll
                for (int bj = 0; bj < 2; ++bj) { const size_t off = (size_t)(row0 + ai * HALF + m * 16) * D + col0 + bj * HALF; f32x4 g0, g1; unpack8(gv[m][bj], g0, g1);
                    f32x4 v0 = acc[ai][bj][m][0] * W8_INV * g0, v1 = acc[ai][bj][m][1] * W8_INV * g1;
                    if (ADD) { f32x4 y0, y1; unpack8(yv[m][bj], y0, y1); v0 += y0; v1 += y1;
                        u32x2 w; w.x = cvt4_fp8(v0[0], v0[1], v0[2], v0[3]); w.y = cvt4_fp8(v1[0], v1[1], v1[2], v1[3]); *(u32x2*)((unsigned char*)O + off) = w; }
                    else *(u32x4*)((bf16*)O + off) = pack8(v0, v1); } }
    }
};
struct EpiX1 {
    static constexpr bool PERM = false; static constexpr bool HAS_PRE = false; static constexpr int NPRE = 0; struct Pre {};
    const float* X; const float* MODF; float* X1;
    __device__ __forceinline__ void operator()(const Acc& acc, const Unit& u, int wr, int wc, int fr, int fq) const {
        const int row0 = u.pm * BM + wr * 64 + fr, col0 = u.pn * BM + wc * 32 + 4 * fq;
        const float* g1 = MODF + (size_t)(u.pm >> 3) * (6 * D) + 2 * D;
        f32x4 gv[2][2];
#pragma unroll
        for (int bj = 0; bj < 2; ++bj)
#pragma unroll
            for (int n = 0; n < 2; ++n) gv[bj][n] = *(const f32x4*)(g1 + col0 + bj * HALF + n * 16);
#pragma unroll
        for (int ai = 0; ai < 2; ++ai) {
            f32x4 xv[4][2][2];
#pragma unroll
            for (int m = 0; m < 4; ++m)
#pragma unroll
                for (int bj = 0; bj < 2; ++bj)
#pragma unroll
                    for (int n = 0; n < 2; ++n) xv[m][bj][n] = *(const f32x4*)(X + (size_t)(row0 + ai * HALF + m * 16) * D + col0 + bj * HALF + n * 16);
#pragma unroll
            for (int m = 0; m < 4; ++m)
#pragma unroll
                for (int bj = 0; bj < 2; ++bj)
#pragma unroll
                    for (int n = 0; n < 2; ++n) *(f32x4*)(X1 + (size_t)(row0 + ai * HALF + m * 16) * D + col0 + bj * HALF + n * 16) = xv[m][bj][n] + gv[bj][n] * (acc[ai][bj][m][n] * W8_INV); }
    }
};
struct EpiUp {
    static constexpr bool PERM = true, HAS_PRE = true; static constexpr int NPRE = 4;
    struct Pre { f32x4 bg0, bg1, bl0, bl1; };
    const float* BGU; unsigned char* ACT;
    __device__ __forceinline__ void pre(Pre& p, const Unit& u, int wr, int wc, int fr, int fq) const {
        const float* bg = BGU + (size_t)u.e * (2 * DFF) + u.pn * 128 + wc * 32 + 8 * fq;
        gload_x4_untracked(p.bg0, bg); gload_x4_untracked(p.bg1, bg + 4); gload_x4_untracked(p.bl0, bg + DFF); gload_x4_untracked(p.bl1, bg + DFF + 4);
    }
    __device__ __forceinline__ void operator()(const Acc& acc, const Unit& u, int wr, int wc, int fr, int fq, const Pre& p) const {
        const int row0 = u.pm * BM + wr * 64 + fr, j0 = u.pn * 128 + wc * 32 + 8 * fq;
        const f32x4 bg0 = p.bg0, bg1 = p.bg1, bl0 = p.bl0, bl1 = p.bl1;
#pragma unroll
        for (int ai = 0; ai < 2; ++ai)
#pragma unroll
            for (int m = 0; m < 4; ++m) { f32x4 o[2];
#pragma unroll
                for (int n = 0; n < 2; ++n) { const f32x4 hg = acc[ai][0][m][n] * W8_INV + (n ? bg1 : bg0), hl = acc[ai][1][m][n] * W8_INV + (n ? bl1 : bl0);
#pragma unroll
                    for (int e = 0; e < 4; ++e) { const float gg = fminf(hg[e], 7.0f), ll = fminf(fmaxf(hl[e], -7.0f), 7.0f); o[n][e] = gg * sigmoidf_(1.702f * gg) * (ll + 1.0f); } }
                u32x2 w; w.x = cvt4_fp8(o[0][0], o[0][1], o[0][2], o[0][3]); w.y = cvt4_fp8(o[1][0], o[1][1], o[1][2], o[1][3]);
                *(u32x2*)(ACT + (size_t)(row0 + ai * HALF + m * 16) * DFF + j0) = w; }
    }
};
struct EpiDown {
    static constexpr bool PERM = true, HAS_PRE = true; static constexpr int NPRE = 12;
    struct Pre { f32x4 bv[2][2]; float gts[2][4]; };
    const float* BD; const float* RG; bf16* YS;
    __device__ __forceinline__ void pre(Pre& p, const Unit& u, int wr, int wc, int fr, int fq) const {
        const float* bd = BD + (size_t)u.e * D + u.pn * BM + wc * 32 + 8 * fq; const int row0 = u.pm * BM + wr * 64 + fr;
#pragma unroll
        for (int bj = 0; bj < 2; ++bj) { gload_x4_untracked(p.bv[bj][0], bd + bj * HALF); gload_x4_untracked(p.bv[bj][1], bd + bj * HALF + 4); }
#pragma unroll
        for (int ai = 0; ai < 2; ++ai)
#pragma unroll
            for (int m = 0; m < 4; ++m) gload_x1_untracked(p.gts[ai][m], RG + row0 + ai * HALF + m * 16);
    }
    __device__ __forceinline__ void operator()(const Acc& acc, const Unit& u, int wr, int wc, int fr, int fq, const Pre& p) const {
        const int row0 = u.pm * BM + wr * 64 + fr, col0 = u.pn * BM + wc * 32 + 8 * fq;
#pragma unroll
        for (int ai = 0; ai < 2; ++ai)
#pragma unroll
            for (int m = 0; m < 4; ++m) { const int row = row0 + ai * HALF + m * 16; const float gt = p.gts[ai][m]; bf16* rowp = YS + (size_t)row * D + col0;
#pragma unroll
                for (int bj = 0; bj < 2; ++bj) *(u32x4*)(rowp + bj * HALF) = pack8((acc[ai][bj][m][0] * W8_INV + p.bv[bj][0]) * gt, (acc[ai][bj][m][1] * W8_INV + p.bv[bj][1]) * gt); }
    }
};
}

namespace att {
constexpr int DH = 128, PITCH = 2048, NW = 8, QBLK = 32, KVBLK = 64, QB = NW * QBLK;
constexpr int SHM_V = KVBLK * DH * 2, SHM_K = KVBLK * DH * 2;
constexpr int ATT_KV_BYTES = 2 * SHM_V + 2 * SHM_K + NW * 64 * 4;
constexpr int MWAVE = 8192;
constexpr int ATT_LDS_BYTES = ATT_KV_BYTES + NW * MWAVE;
constexpr float SCALE = 0.08838834764831845f, THR = 8.f;
#define KSWZ(row, colB) ((row) * 256 + ((colB) ^ (((row) & 7) << 4)))
#define SBAR() __builtin_amdgcn_sched_barrier(0)
__device__ __forceinline__ int v_st(int k, int c) { const int kk = (k & ~0xC) | ((k & 4) << 1) | ((k & 8) >> 1); return ((kk >> 3) * 4 + (c >> 5)) * 512 + ((kk & 7) * 32 + (c & 31)) * 2; }
__device__ __forceinline__ int v_rd_base(int lane) { return ((lane & 3) << 3) | (((lane >> 2) & 3) << 6) | (((lane >> 4) & 1) << 5) | (((lane >> 5) & 1) << 8); }
constexpr int v_rd_off(int d0, int ks, int half) { return d0 * 512 + ks * 4096 + half * 2048; }
__device__ __forceinline__ int crow(int r, int hi) { return (r & 3) + 8 * (r >> 2) + 4 * hi; }
__device__ __forceinline__ bf16x8 load8(const bf16* p) { return *reinterpret_cast<const bf16x8*>(p); }
__device__ __forceinline__ void mask_bits(f32x16& p0, f32x16& p1, unsigned w0, unsigned w1, int hi) {
    const unsigned a0 = w0 >> (4 * hi), a1 = w1 >> (4 * hi);
    const unsigned NEGB = 0xff800000u;
#pragma unroll
    for (int r = 0; r < 16; ++r) {
        const int c = (r & 3) + 8 * (r >> 2);
        const unsigned m0 = (unsigned)__builtin_amdgcn_sbfe((int)a0, c, 1), m1 = (unsigned)__builtin_amdgcn_sbfe((int)a1, c, 1);
        p0[r] = __uint_as_float((__float_as_uint(p0[r]) & m0) | (NEGB & ~m0));
        p1[r] = __uint_as_float((__float_as_uint(p1[r]) & m1) | (NEGB & ~m1));
    }
}
__device__ __forceinline__ void partialSM(f32x16& p0, f32x16& p1, float& m_reg, float& mn, float& alpha) {
    float pmax = p0[0];
#pragma unroll
    for (int r = 1; r < 16; ++r) pmax = fmaxf(pmax, p0[r]);
#pragma unroll
    for (int r = 0; r < 16; ++r) pmax = fmaxf(pmax, p1[r]);
    { auto rr = __builtin_amdgcn_permlane32_swap(__float_as_uint(pmax), __float_as_uint(pmax), false, false);
      pmax = fmaxf(__uint_as_float(rr[0]), __uint_as_float(rr[1])); }
    constexpr float C2 = 1.4426950408889634f * SCALE;
    if (__builtin_expect(__all((pmax - m_reg) * SCALE <= THR), 1)) { mn = m_reg; alpha = 1.f; }
    else { mn = fmaxf(m_reg, pmax); alpha = __builtin_amdgcn_exp2f((m_reg - mn) * C2); m_reg = mn; }
    const float mnL = -mn * C2;
#pragma unroll
    for (int r = 0; r < 16; ++r) p0[r] = fmaf(p0[r], C2, mnL);
#pragma unroll
    for (int r = 0; r < 16; ++r) p1[r] = fmaf(p1[r], C2, mnL);
#pragma unroll
    for (int r = 0; r < 16; ++r) p0[r] = __builtin_amdgcn_exp2f(p0[r]);
}
__device__ __forceinline__ void finishSM(f32x16& p0, f32x16& p1, float alpha, float& l_reg, bf16x8& pa0, bf16x8& pa1, bf16x8& pa2, bf16x8& pa3) {
#pragma unroll
    for (int r = 0; r < 16; ++r) p1[r] = __builtin_amdgcn_exp2f(p1[r]);
    float ps = 0;
#pragma unroll
    for (int r = 0; r < 16; ++r) ps += p0[r];
#pragma unroll
    for (int r = 0; r < 16; ++r) ps += p1[r];
    { auto rr = __builtin_amdgcn_permlane32_swap(__float_as_uint(ps), __float_as_uint(ps), false, false);
      ps = __uint_as_float(rr[0]) + __uint_as_float(rr[1]); }
    l_reg = l_reg * alpha + ps;
#define PK4(P, B_, OUT) do { unsigned a0 = cvtpk(P[B_+0], P[B_+1]), a1 = cvtpk(P[B_+2], P[B_+3]);                          \
        unsigned b0 = cvtpk(P[B_+4], P[B_+5]), b1 = cvtpk(P[B_+6], P[B_+7]);                                             \
        auto r0 = __builtin_amdgcn_permlane32_swap(a0, b0, false, false); auto r1 = __builtin_amdgcn_permlane32_swap(a1, b1, false, false); \
        u32x4 w = {r0[0], r1[0], r0[1], r1[1]}; OUT = *reinterpret_cast<bf16x8*>(&w); } while (0)
    PK4(p0, 0, pa0); PK4(p0, 8, pa1); PK4(p1, 0, pa2); PK4(p1, 8, pa3);
#undef PK4
}
template <int KB>
__device__ __forceinline__ void qkt(f32x16& p0, f32x16& p1, const char* K_lds, int r32, int hi, const bf16x8* qr) {
    p0 = f32x16{}; p1 = f32x16{};
    const char* kb[4];
#pragma unroll
    for (int dd = 0; dd < 4; ++dd) kb[dd] = K_lds + KB * SHM_K + KSWZ(r32, (dd * 16 + hi * 8) * 2);
#pragma unroll
    for (int d0 = 0; d0 < 8; ++d0) { const char* a = kb[d0 & 3] + (d0 >> 2) * 128;
        bf16x8 b0 = *reinterpret_cast<const bf16x8*>(a);
        bf16x8 b1 = *reinterpret_cast<const bf16x8*>(a + 32 * 256);
        p0 = __builtin_amdgcn_mfma_f32_32x32x16_bf16(b0, qr[d0], p0, 0, 0, 0);
        p1 = __builtin_amdgcn_mfma_f32_32x32x16_bf16(b1, qr[d0], p1, 0, 0, 0); }
}
template <int VB>
__device__ __forceinline__ void pv_tile(f32x16* o, int vb0, bf16x8 pa0, bf16x8 pa1, bf16x8 pa2, bf16x8 pa3) {
#define TRRD(dst, off) asm volatile("ds_read_b64_tr_b16 %0, %1 offset:%2" : "=&v"(dst) : "v"(vb0), "i"(off) : "memory")
#define PV_D0(d0) do { s16x4 l0, l1, l2, l3, h0, h1, h2, h3; constexpr int b_ = VB * SHM_V + v_rd_off(d0, 0, 0); \
        TRRD(l0, b_); TRRD(h0, b_ + 2048); TRRD(l1, b_ + 4096); TRRD(h1, b_ + 6144); TRRD(l2, b_ + 8192); TRRD(h2, b_ + 10240); TRRD(l3, b_ + 12288); TRRD(h3, b_ + 14336); \
        asm volatile("s_waitcnt lgkmcnt(0)" ::: "memory"); SBAR();   \
        o[d0] = __builtin_amdgcn_mfma_f32_32x32x16_bf16(pa0, (bf16x8){l0[0], l0[1], l0[2], l0[3], h0[0], h0[1], h0[2], h0[3]}, o[d0], 0, 0, 0);   \
        o[d0] = __builtin_amdgcn_mfma_f32_32x32x16_bf16(pa1, (bf16x8){l1[0], l1[1], l1[2], l1[3], h1[0], h1[1], h1[2], h1[3]}, o[d0], 0, 0, 0);   \
        o[d0] = __builtin_amdgcn_mfma_f32_32x32x16_bf16(pa2, (bf16x8){l2[0], l2[1], l2[2], l2[3], h2[0], h2[1], h2[2], h2[3]}, o[d0], 0, 0, 0);   \
        o[d0] = __builtin_amdgcn_mfma_f32_32x32x16_bf16(pa3, (bf16x8){l3[0], l3[1], l3[2], l3[3], h3[0], h3[1], h3[2], h3[3]}, o[d0], 0, 0, 0); } while (0)
    PV_D0(0); PV_D0(1); PV_D0(2); PV_D0(3);
#undef PV_D0
#undef TRRD
}

struct BlockRef { const bf16* Q; const bf16* K; const bf16* V; bf16* O; const unsigned* M; int P0; };
struct Seam { bf16x8 qr[8]; bf16x8 st_v0, st_v1, st_k0, st_k1; };
#define ROW(p, k0, r32c) ((const bf16*)((const char*)(p) + (size_t)((k0) + (r32c)) * (PITCH * 2) + rvo))
#define VMW() asm volatile("s_waitcnt vmcnt(0)" ::: "memory")
#define VMWN(n) asm volatile("s_waitcnt vmcnt(%0)" :: "i"(n) : "memory")
#define SLOAD_H(Kp, Vp, k0) do { S.st_v0 = load8(ROW(Vp, k0, 0)); S.st_v1 = load8(ROW(Vp, k0, 32));              \
                         S.st_k0 = load8(ROW(Kp, k0, 0)); S.st_k1 = load8(ROW(Kp, k0, 32)); } while (0)
#define SWRITE_HK(bf) do { *(bf16x8*)(K_lds + (bf) * SHM_K + kws) = S.st_k0; *(bf16x8*)(K_lds + (bf) * SHM_K + kws + 32 * 256) = S.st_k1; } while (0)
#define SWRITE_HV(bf) do { *(bf16x8*)(V_lds + (bf) * SHM_V + vst0) = S.st_v0; *(bf16x8*)(V_lds + (bf) * SHM_V + vst1) = S.st_v1; } while (0)
#define SWRITE_H(bf) do { SWRITE_HV(bf); SWRITE_HK(bf); } while (0)
__device__ __forceinline__ void mask_dma(const BlockRef& b, char* lds, int wid, int r32, int hi) {
    const int nt = (b.P0 + QB - 1) / KVBLK + 1;
    const char* mg = (const char*)b.M + (unsigned)((wid * QBLK + r32) * 256 + 16 * hi);
    LAS char* ml = (LAS char*)lds + ATT_KV_BYTES + wid * MWAVE;
    for (int jj = 0; jj < (nt + 3) / 4; ++jj) __builtin_amdgcn_global_load_lds((const unsigned*)(mg + 32 * jj), (LAS unsigned*)(ml + 1024 * jj), 16, 0, 0);
}
#define MASK_RD(t) (*(const LAS u32x2*)(mlane + (((t) >> 2) * 1024 + (((t) >> 1) & 1) * 512 + ((t) & 1) * 8)))
__device__ __forceinline__ void attn_prime(const BlockRef& cur, char* lds, Seam& S) {
    const int tid = threadIdx.x, wid = __builtin_amdgcn_readfirstlane(tid >> 6), lane = tid & 63, r32 = lane & 31, hi = lane >> 5;
    const int sr = tid >> 4, sc = (tid & 15) * 8, kws = KSWZ(sr, sc * 2); char* K_lds = lds + 2 * SHM_V; const unsigned rvo = (unsigned)((sr * PITCH + sc) * 2);
#pragma unroll
    for (int d0 = 0; d0 < 8; ++d0) S.qr[d0] = load8((const bf16*)((const char*)cur.Q + (unsigned)(((wid * QBLK + r32) * PITCH + hi * 8) * 2 + d0 * 32)));
    SLOAD_H(cur.K, cur.V, 0); mask_dma(cur, lds, wid, r32, hi); VMW(); SWRITE_HK(0);
    __syncthreads();
}
__device__ __forceinline__ void attn_block(const BlockRef& cur, const BlockRef& nxt, char* lds, Seam& S) {
    const int tid = threadIdx.x, wid = __builtin_amdgcn_readfirstlane(tid >> 6), lane = tid & 63, r32 = lane & 31, hi = lane >> 5;
    const int NT = (cur.P0 + QB - 1) / KVBLK + 1;
    char* V_lds = lds; char* K_lds = lds + 2 * SHM_V;
    float* ws = (float*)(lds + 2 * SHM_V + 2 * SHM_K) + wid * 64; float* li_l = ws, * al_l = ws + 32;
    float m_reg = -1e30f, l_reg = 0; f32x16 o[4] = {};
    const int sr = tid >> 4, sc = (tid & 15) * 8, vst0 = v_st(sr, sc), vst1 = v_st(32 + sr, sc), kws = KSWZ(sr, sc * 2); const unsigned rvo = (unsigned)((sr * PITCH + sc) * 2);
    const int vb0 = (int)(uintptr_t)V_lds + v_rd_base(lane);
    const bf16* Kh = cur.K; const bf16* Vh = cur.V;
    LAS char* mlane = (LAS char*)lds + ATT_KV_BYTES + wid * MWAVE + r32 * 16;
#define RESC(a) do { if (__any((a) < 1.f)) { if (hi == 0) al_l[r32] = (a); asm volatile("s_waitcnt lgkmcnt(0)" ::: "memory");              \
                     for (int d_ = 0; d_ < 4; ++d_) for (int r = 0; r < 16; ++r) o[d_][r] *= al_l[crow(r, hi)]; } } while (0)
#define KBASE(t) ((t) * KVBLK)
#ifdef ATT_NOMASK
#define MASKT(P0_, P1_, mw_) do { } while (0)
#else
#define MASKT(P0_, P1_, mw_) do { unsigned w0_ = (mw_).x, w1_ = (mw_).y; asm volatile("" : "+v"(w0_), "+v"(w1_)); mask_bits(P0_, P1_, w0_, w1_, hi); } while (0)
#endif
    constexpr int NQL = 8;
#define SEAM_K0() do { VMWN(NQL); SWRITE_HK(0); SBAR(); } while (0)
    f32x16 pA0, pA1, pB0, pB1; float mnA, mnB, alA, alB; bf16x8 pa0, pa1, pa2, pa3;
    { SWRITE_HV(0); SBAR();
      SLOAD_H(Kh, Vh, KBASE(1));
      SBAR(); qkt<0>(pA0, pA1, K_lds, r32, hi, S.qr);
      VMWN(4);
      { const u32x2 mw0 = MASK_RD(0); MASKT(pA0, pA1, mw0); } partialSM(pA0, pA1, m_reg, mnA, alA); }
    if (NT > 1) { VMW(); SWRITE_H(1); }
    __syncthreads();
#define HALF_STEP(PX0, PX1, mnX, alX, PY0, PY1, alY, t, KB, VB, SB) do {                                                      \
        SBAR(); qkt<KB>(PX0, PX1, K_lds, r32, hi, S.qr);                                                                      \
        finishSM(PY0, PY1, alY, l_reg, pa0, pa1, pa2, pa3); SBAR();                                                           \
        if ((t) + 1 < NT) { SLOAD_H(Kh, Vh, KBASE((t) + 1)); SBAR(); }                                                        \
        pv_tile<VB>(o, vb0, pa0, pa1, pa2, pa3); { const u32x2 mw_ = MASK_RD(t); MASKT(PX0, PX1, mw_); } partialSM(PX0, PX1, m_reg, mnX, alX);                  \
        __syncthreads();                                                                                                      \
        if ((t) + 1 < NT) { VMW(); SWRITE_H(SB); }                                                                            \
        RESC(alX); __syncthreads(); } while (0)
    for (int t = 1; t + 1 < NT; t += 2) {
        HALF_STEP(pB0, pB1, mnB, alB, pA0, pA1, alA, t, 1, 0, 0);
        HALF_STEP(pA0, pA1, mnA, alA, pB0, pB1, alB, t + 1, 0, 1, 1);
    }
    const bool even = (NT & 1) == 0;
    if (even) { SBAR(); qkt<1>(pB0, pB1, K_lds, r32, hi, S.qr); SBAR(); }
    SLOAD_H(nxt.K, nxt.V, 0); SBAR();
#pragma unroll
    for (int d0 = 0; d0 < 8; ++d0) S.qr[d0] = load8((const bf16*)((const char*)nxt.Q + (unsigned)(((wid * QBLK + r32) * PITCH + hi * 8) * 2 + d0 * 32)));
    SBAR();
    finishSM(pA0, pA1, alA, l_reg, pa0, pa1, pa2, pa3); SBAR();
    pv_tile<0>(o, vb0, pa0, pa1, pa2, pa3);
    if (even) { { const u32x2 mwl = MASK_RD(NT - 1); MASKT(pB0, pB1, mwl); } partialSM(pB0, pB1, m_reg, mnB, alB); __syncthreads(); RESC(alB);
        finishSM(pB0, pB1, alB, l_reg, pa0, pa1, pa2, pa3); SBAR(); pv_tile<1>(o, vb0, pa0, pa1, pa2, pa3); }
    SBAR(); asm volatile("s_waitcnt lgkmcnt(0)" ::: "memory"); mask_dma(nxt, lds, wid, r32, hi); SBAR(); SEAM_K0();
    if (hi == 0) li_l[r32] = l_reg; asm volatile("s_waitcnt lgkmcnt(0)" ::: "memory");
    int tz; asm volatile("v_mbcnt_lo_u32_b32 %0, -1, 0\n\tv_mbcnt_hi_u32_b32 %0, -1, %0" : "=v"(tz)); const int hib = (tz >> 5) & 1, r32b = tz & 31, widb = wid;
    float rli[16];
#pragma unroll
    for (int r = 0; r < 16; ++r) rli[r] = __builtin_amdgcn_rcpf(li_l[crow(r, hib)]);
    unsigned char* Ow = (unsigned char*)cur.O + (unsigned)((widb * QBLK + 4 * hib) * PITCH + 4 * r32b);
#pragma unroll
    for (int r = 0; r < 16; ++r) {
        *(GAS unsigned*)Ow = cvt4_fp8(o[0][r] * rli[r], o[1][r] * rli[r], o[2][r] * rli[r], o[3][r] * rli[r]);
        Ow += ((r & 3) == 3 ? 5 : 1) * PITCH; asm volatile("" : "+v"(Ow)); }
    __syncthreads();
#undef RESC
#undef KBASE
#undef MASKT
#undef SEAM_K0
#undef HALF_STEP
}
#undef ROW
#undef SLOAD_H
#undef SWRITE_HK
#undef SWRITE_HV
#undef SWRITE_H
}

#define XB_TMO      128
#define XB_XCNT(j)  (256  + 64 * (j))
#define XB_XSUB(j)  (1280 + 64 * (j))
#define XB_XGEN(j)  (2304 + 64 * (j))
#define XB_TOP      3328
#define XB_TOPGEN   3392
#define XCD_BAR_WORDS 3456
#define XB_SPIN_CAP (1u << 18)
__device__ __forceinline__ unsigned xb_ld(unsigned* p)              { return __hip_atomic_load(p, __ATOMIC_RELAXED, __HIP_MEMORY_SCOPE_AGENT); }
__device__ __forceinline__ unsigned xb_add(unsigned* p, unsigned v) { return __hip_atomic_fetch_add(p, v, __ATOMIC_RELAXED, __HIP_MEMORY_SCOPE_AGENT); }
__device__ __forceinline__ unsigned xb_xcc_id() { return (unsigned)__builtin_amdgcn_s_getreg((3 << 11) | 20) & 0xFu; }
#define XB_SPIN(cond, bar) do { unsigned _sp = 0; while (cond) { __builtin_amdgcn_s_sleep(1); \
    if ((++_sp & 255u) == 0u) { if (xb_ld(&(bar)[XB_TMO])) break; if (_sp > XB_SPIN_CAP) { atomicAdd(&(bar)[XB_TMO], 1u); break; } } } } while (0)
struct XcdBarrier { unsigned* bar; unsigned x; volatile LAS unsigned* st; };
__device__ __forceinline__ XcdBarrier xcd_barrier_post(unsigned* bar, volatile LAS unsigned* st) {
    XcdBarrier b; b.bar = bar; b.x = xb_xcc_id(); b.st = st;
    if (threadIdx.x == 0) (void)xb_add(&bar[XB_XCNT(b.x)], 1u);
    return b;
}
__device__ __forceinline__ void xcd_barrier_complete(unsigned* bar, unsigned x, unsigned& nloc, unsigned& nx) {
    const unsigned G = gridDim.x * gridDim.y * gridDim.z;
    unsigned sum, cnt, mine, sp = 0u;
    for (;;) {
        sum = 0u; cnt = 0u; mine = 0u;
#pragma unroll
        for (unsigned j = 0; j < 16; ++j) { const unsigned c = xb_ld(&bar[XB_XCNT(j)]); sum += c; cnt += (c > 0u) ? 1u : 0u; mine = (j == x) ? c : mine; }
        if (sum == G) break;
        __builtin_amdgcn_s_sleep(1);
        if ((++sp & 255u) == 0u) { if (xb_ld(&bar[XB_TMO])) break; if (sp > XB_SPIN_CAP) { atomicAdd(&bar[XB_TMO], 1u); break; } }
    }
    nloc = mine > 0u ? mine : 1u; nx = cnt > 0u ? cnt : 1u;
}
__device__ __forceinline__ void xcd_barrier(const XcdBarrier& b) {
    asm volatile("s_waitcnt vmcnt(0)" ::: "memory");
    __syncthreads();
    if (threadIdx.x == 0) {
        unsigned* bar = b.bar;
        __builtin_amdgcn_s_waitcnt(0);
        unsigned nloc = b.st[0], nx = b.st[1];
        if (nloc == 0u) { xcd_barrier_complete(bar, b.x, nloc, nx); b.st[0] = nloc; b.st[1] = nx; }
        const unsigned old = xb_add(&bar[XB_XSUB(b.x)], 1u);
        const unsigned gen = old / nloc;
        if (old + 1u == (gen + 1u) * nloc) {
            __builtin_amdgcn_fence(__ATOMIC_RELEASE, "agent");
            asm volatile("s_waitcnt vmcnt(0)" ::: "memory");
            const unsigned og = xb_add(&bar[XB_TOP], 1u);
            const unsigned tg = og / nx;
            if (og + 1u == (tg + 1u) * nx) xb_add(&bar[XB_TOPGEN], 1u);
            else XB_SPIN(xb_ld(&bar[XB_TOPGEN]) == tg, bar);
            __builtin_amdgcn_fence(__ATOMIC_ACQUIRE, "agent");
            xb_add(&bar[XB_XGEN(b.x)], 1u);
            asm volatile("s_waitcnt vmcnt(0)" ::: "memory");
        } else {
            XB_SPIN(xb_ld(&bar[XB_XGEN(b.x)]) == gen, bar);
            __builtin_amdgcn_fence(__ATOMIC_ACQUIRE, "agent");
            asm volatile("s_waitcnt vmcnt(0)" ::: "memory");
        }
    }
    __syncthreads();
}

struct Args { const float* in[23]; float* out; unsigned char* ws; int ph_lo, ph_hi; };
enum { I_X = 0, I_C, I_WMOD, I_BMOD, I_N1G, I_WIN, I_KVG, I_WUK, I_WUV, I_WPA, I_SGG, I_WSP, I_BSP, I_WPB, I_WOUT, I_N2G, I_WR, I_BR, I_WGU, I_BGU, I_WD, I_BD, I_FG };

struct Frame { LAS unsigned char* lds; int tid, lane, wave, vcu, G; };

template <class SrcF>
__device__ __forceinline__ void transpose_item(const float* W, int ldw, bf16* WT, int ldt, int k0, int n0, LAS float* scr, int lane, SrcF srcf, const float* kscale) {
    const int sc = srcf(n0 + (lane & 31));
    float tv[32];
#pragma unroll
    for (int i = 0; i < 32; ++i) { const int kk = 2 * i + (lane >> 5); tv[i] = W[(size_t)(k0 + kk) * ldw + (sc >= 0 ? sc : 0)]; }
#pragma unroll
    for (int i = 0; i < 32; ++i) { const int kk = 2 * i + (lane >> 5); float v = sc >= 0 ? tv[i] : 0.f; if (kscale) v *= kscale[k0 + kk]; scr[kk * 33 + (lane & 31)] = v; }
    LDS_WAIT(); asm volatile("" ::: "memory");
    const int c = lane & 7;
#pragma unroll
    for (int j = 0; j < 4; ++j) { const int n = (lane >> 3) + 8 * j; const LAS float* s = scr + (8 * c) * 33 + n;
        u32x4 o; o.x = cvtpk(s[0 * 33], s[1 * 33]); o.y = cvtpk(s[2 * 33], s[3 * 33]); o.z = cvtpk(s[4 * 33], s[5 * 33]); o.w = cvtpk(s[6 * 33], s[7 * 33]);
        *(u32x4*)(WT + (size_t)(n0 + n) * ldt + k0 + 8 * c) = o; }
    LDS_WAIT(); asm volatile("" ::: "memory");
}

template <bool F8, class DRow>
__device__ __forceinline__ void conv_item(const float* W, int ldw, int N, void* WT, int ldt, int k0, int c0, int lane, DRow drow, float scale) {
    constexpr int KS = F8 ? 16 : 8, NSTEP = 8;
    const int c = c0 + 4 * lane; const bool ok = c + 3 < N;
    const float* src = W + (size_t)k0 * ldw + (ok ? c : 0);
    char* dp[4];
#pragma unroll
    for (int j = 0; j < 4; ++j) dp[j] = (char*)WT + ((size_t)drow(ok ? c + j : 0) * ldt + k0) * (F8 ? 1 : 2);
    f32x4 cur[KS], nxt[KS];
#pragma unroll
    for (int i = 0; i < KS; ++i) cur[i] = *(const f32x4*)(src + (size_t)i * ldw);
#pragma unroll
    for (int st = 0; st < NSTEP; ++st) {
        if (st + 1 < NSTEP) {
#pragma unroll
            for (int i = 0; i < KS; ++i) nxt[i] = *(const f32x4*)(src + (size_t)((st + 1) * KS + i) * ldw); }
#pragma unroll
        for (int j = 0; j < 4; ++j) { u32x4 o;
            if constexpr (F8) { o.x = cvt4_fp8(cur[0][j] * scale, cur[1][j] * scale, cur[2][j] * scale, cur[3][j] * scale); o.y = cvt4_fp8(cur[4][j] * scale, cur[5][j] * scale, cur[6][j] * scale, cur[7][j] * scale);
                                o.z = cvt4_fp8(cur[8][j] * scale, cur[9][j] * scale, cur[10][j] * scale, cur[11][j] * scale); o.w = cvt4_fp8(cur[12][j] * scale, cur[13][j] * scale, cur[14][j] * scale, cur[15][j] * scale); }
            else { o.x = cvtpk(cur[0][j], cur[1][j]); o.y = cvtpk(cur[2][j], cur[3][j]); o.z = cvtpk(cur[4][j], cur[5][j]); o.w = cvtpk(cur[6][j], cur[7][j]); }
            if (ok) *(u32x4*)(dp[j] + st * 16) = o; }
        if (st + 1 < NSTEP) {
#pragma unroll
            for (int i = 0; i < KS; ++i) cur[i] = nxt[i]; }
    }
}

template <class SrcF>
__device__ __forceinline__ void transpose_item8(const float* W, int ldw, unsigned char* WT, int ldt, int k0, int n0, LAS float* scr, int lane, SrcF srcf, float scale) {
    const int sc = srcf(n0 + (lane & 31));
    float tv[64];
#pragma unroll
    for (int i = 0; i < 64; ++i) { const int kk = 2 * i + (lane >> 5); tv[i] = W[(size_t)(k0 + kk) * ldw + sc]; }
#pragma unroll
    for (int i = 0; i < 64; ++i) { const int kk = 2 * i + (lane >> 5); scr[kk * 33 + (lane & 31)] = tv[i] * scale; }
    LDS_WAIT(); asm volatile("" ::: "memory");
    const int c = lane & 7;
#pragma unroll
    for (int j = 0; j < 4; ++j) { const int n = (lane >> 3) + 8 * j; const LAS float* s = scr + (16 * c) * 33 + n;
        u32x4 o; o.x = cvt4_fp8(s[0 * 33], s[1 * 33], s[2 * 33], s[3 * 33]); o.y = cvt4_fp8(s[4 * 33], s[5 * 33], s[6 * 33], s[7 * 33]);
        o.z = cvt4_fp8(s[8 * 33], s[9 * 33], s[10 * 33], s[11 * 33]); o.w = cvt4_fp8(s[12 * 33], s[13 * 33], s[14 * 33], s[15 * 33]);
        *(u32x4*)(WT + (size_t)(n0 + n) * ldt + k0 + 16 * c) = o; }
    LDS_WAIT(); asm volatile("" ::: "memory");
}

__device__ __forceinline__ void moe_conv(const Frame& F, const Args& a) {
    unsigned char* ws = a.ws;
    { constexpr int TPE_GU = 16 * 32, TPE_DN = 16 * 16, NT_GU = NE * TPE_GU, NTILE = NT_GU + NE * TPE_DN;
      LAS unsigned char* fb = F.lds;
      LAS unsigned* stg = (LAS unsigned*)(F.lds + 131072);
      auto issue = [&](int t, int buf) {
          const float* W; int ldw, k0, c0;
          if (t < NT_GU) { const int e = t / TPE_GU, q = t % TPE_GU; W = a.in[I_WGU] + (size_t)e * D * (2 * DFF); ldw = 2 * DFF; k0 = 128 * (q & 15); c0 = 128 * (q >> 4); }
          else { const int r = t - NT_GU, e = r / TPE_DN, q = r % TPE_DN; W = a.in[I_WD] + (size_t)e * DFF * D; ldw = D; k0 = 128 * (q & 15); c0 = 128 * (q >> 4); }
          const float* p = W + (size_t)(k0 + 16 * F.wave + (F.lane >> 5)) * ldw + c0 + 4 * (F.lane & 31);
#pragma unroll
          for (int i = 0; i < 8; ++i)
              __builtin_amdgcn_global_load_lds((const unsigned*)(p + (size_t)(2 * i) * ldw), (LAS unsigned*)(fb + buf * 65536 + (16 * F.wave + 2 * i) * 512), 16, 0, 2); };
      auto convert = [&](int buf) {
          const LAS unsigned char* src = fb + buf * 65536 + (16 * F.wave) * 512 + F.lane * 8;
          f32x2 v[16];
#pragma unroll
          for (int r = 0; r < 16; ++r) v[r] = *(const LAS f32x2*)(src + r * 512);
#pragma unroll
          for (int kq = 0; kq < 4; ++kq) { u32x2 w;
              w.x = cvt4_fp8(v[4 * kq][0] * W8_SCALE, v[4 * kq + 1][0] * W8_SCALE, v[4 * kq + 2][0] * W8_SCALE, v[4 * kq + 3][0] * W8_SCALE);
              w.y = cvt4_fp8(v[4 * kq][1] * W8_SCALE, v[4 * kq + 1][1] * W8_SCALE, v[4 * kq + 2][1] * W8_SCALE, v[4 * kq + 3][1] * W8_SCALE);
              *(LAS u32x2*)(stg + (4 * F.wave + kq) * 128 + 2 * F.lane) = w; } };
      auto store_tile = [&](int t) {
          unsigned char* WT; int ldt, k0, c0; const bool gu = t < NT_GU;
          if (gu) { const int e = t / TPE_GU, q = t % TPE_GU; WT = (unsigned char*)(ws + WS_WGU) + (size_t)e * (2 * DFF) * D; ldt = D; k0 = 128 * (q & 15); c0 = 128 * (q >> 4); }
          else { const int r = t - NT_GU, e = r / TPE_DN, q = r % TPE_DN; WT = (unsigned char*)(ws + WS_WD) + (size_t)e * D * DFF; ldt = DFF; k0 = 128 * (q & 15); c0 = 128 * (q >> 4); }
          const int c = F.tid & 7;
#pragma unroll
          for (int j = 0; j < 2; ++j) { const int nl = (F.tid >> 3) + 64 * j, n = c0 + nl; const LAS unsigned* sp = stg + (4 * c) * 128 + nl;
              u32x4 o; o.x = sp[0]; o.y = sp[128]; o.z = sp[256]; o.w = sp[384];
              const int drow = gu ? (((n & 2047) >> 7) * 256 + (n >> 11) * 128 + (n & 127)) : n;
              __builtin_nontemporal_store(o, (u32x4*)(WT + (size_t)drow * ldt + k0 + 16 * c)); } };
#define MC_STEP(s_, buf_) do { if ((s_) > 0) store_tile(tix((s_) - 1)); LDS_BARRIER(); \
          asm volatile("s_waitcnt vmcnt(8)" ::: "memory"); convert(buf_); asm volatile("s_waitcnt lgkmcnt(0)" ::: "memory"); issue(tix((s_) + 2), buf_); LDS_BARRIER(); } while (0)
      const int t0 = F.vcu, nw = t0 < NTILE ? (NTILE - 1 - t0) / F.G + 1 : 0;
      if (nw > 0) {
          const int tl = t0 + (nw - 1) * F.G;
          auto tix = [&](int s) { const int x = t0 + s * F.G; return x < tl ? x : tl; };
          issue(tix(0), 0); issue(tix(1), 1);
#pragma unroll 1
          for (int s = 0; s < nw; s += 2) { MC_STEP(s, 0); MC_STEP(s + 1, 1); }
          store_tile(tl);
          VM_WAIT(); }
#undef MC_STEP
      __syncthreads(); }
}

__device__ __forceinline__ void win_conv(const Frame& F, const Args& a) {
    unsigned char* ws = a.ws;
    constexpr int NT_B = 16 * (NIN_B / 128), NT_A = 16 * (NIN_A / 128), NT_SQ = 16 * 16, NTILE = NT_B + NT_A + 3 * NT_SQ;
    LAS unsigned char* fb = F.lds;
    LAS unsigned* stg = (LAS unsigned*)(F.lds + 131072);
    auto decode = [&](int t, const float*& src, int& ldw, int& valid, unsigned char*& dst) {
        if (t < NT_B) { const int kb = t & 15, n0 = 128 * (t >> 4); src = a.in[I_WIN] + (size_t)(128 * kb) * NIN_SRC + (n0 < 2304 ? n0 : n0 + 2192); ldw = NIN_SRC; valid = 128;
            dst = (unsigned char*)(ws + WS_WIN8) + (size_t)n0 * D + 128 * kb; return; }
        t -= NT_B;
        if (t < NT_A) { const int kb = t & 15, n0 = 128 * (t >> 4); src = a.in[I_WIN] + (size_t)(128 * kb) * NIN_SRC + n0 + 2304; ldw = NIN_SRC; valid = 2192 - n0 < 128 ? 2192 - n0 : 128;
            dst = (unsigned char*)(ws + WS_WIN) + (size_t)n0 * D + 128 * kb; return; }
        t -= NT_A;
        { const int w = t / NT_SQ, q = t % NT_SQ, kb = q & 15, n0 = 128 * (q >> 4);
          src = (w == 0 ? a.in[I_WPA] : (w == 1 ? a.in[I_WPB] : a.in[I_WOUT])) + (size_t)(128 * kb) * D + n0; ldw = D; valid = 128;
          dst = (unsigned char*)(ws + (w == 0 ? WS_WPA : (w == 1 ? WS_WPB : WS_WOUT))) + (size_t)n0 * D + 128 * kb; } };
    auto issue = [&](int t, int buf) {
        const float* src; int ldw, valid; unsigned char* dst; decode(t, src, ldw, valid, dst);
        int col = 4 * (F.lane & 31); col = col < valid ? col : valid - 4;
        const float* p = src + (size_t)(16 * F.wave + (F.lane >> 5)) * ldw + col;
#pragma unroll
        for (int i = 0; i < 8; ++i)
            __builtin_amdgcn_global_load_lds((const unsigned*)(p + (size_t)(2 * i) * ldw), (LAS unsigned*)(fb + buf * 65536 + (16 * F.wave + 2 * i) * 512), 16, 0, 0); };
    auto convert = [&](int buf) {
        const LAS unsigned char* s = fb + buf * 65536 + (16 * F.wave) * 512 + F.lane * 8;
        f32x2 v[16];
#pragma unroll
        for (int r = 0; r < 16; ++r) v[r] = *(const LAS f32x2*)(s + r * 512);
#pragma unroll
        for (int kq = 0; kq < 4; ++kq) { u32x2 w;
            w.x = cvt4_fp8(v[4 * kq][0] * W8_SCALE, v[4 * kq + 1][0] * W8_SCALE, v[4 * kq + 2][0] * W8_SCALE, v[4 * kq + 3][0] * W8_SCALE);
            w.y = cvt4_fp8(v[4 * kq][1] * W8_SCALE, v[4 * kq + 1][1] * W8_SCALE, v[4 * kq + 2][1] * W8_SCALE, v[4 * kq + 3][1] * W8_SCALE);
            *(LAS u32x2*)(stg + (4 * F.wave + kq) * 128 + 2 * F.lane) = w; } };
    auto store_tile = [&](int t) {
        const float* src; int ldw, valid; unsigned char* dst; decode(t, src, ldw, valid, dst);
        const int c = F.tid & 7;
#pragma unroll
        for (int j = 0; j < 2; ++j) { const int nl = (F.tid >> 3) + 64 * j; const LAS unsigned* sp = stg + (4 * c) * 128 + nl;
            u32x4 o; o.x = sp[0]; o.y = sp[128]; o.z = sp[256]; o.w = sp[384];
            *(u32x4*)(dst + (size_t)nl * D + 16 * c) = o; } };
#define WC_STEP(s_, buf_) do { if ((s_) > 0) store_tile(tix((s_) - 1)); LDS_BARRIER(); \
        asm volatile("s_waitcnt vmcnt(8)" ::: "memory"); convert(buf_); asm volatile("s_waitcnt lgkmcnt(0)" ::: "memory"); issue(tix((s_) + 2), buf_); LDS_BARRIER(); } while (0)
    const int t0 = F.vcu, nw = t0 < NTILE ? (NTILE - 1 - t0) / F.G + 1 : 0;
    if (nw > 0) {
        const int tl = t0 + (nw - 1) * F.G;
        auto tix = [&](int s) { const int x = t0 + s * F.G; return x < tl ? x : tl; };
        issue(tix(0), 0); issue(tix(1), 1);
#pragma unroll 1
        for (int s = 0; s < nw; s += 2) { WC_STEP(s, 0); WC_STEP(s + 1, 1); }
        store_tile(tl);
        VM_WAIT(); }
#undef WC_STEP
    __syncthreads();
}


__device__ __forceinline__ void p0_prologue(const Frame& F, const Args& a) {
    unsigned char* ws = a.ws;
    const int gw = F.vcu * NWAVES + F.wave, NGW = F.G * NWAVES;
    {
    LAS float* csil = (LAS float*)F.lds;
    { float cv[32];
#pragma unroll
      for (int q = 0; q < 32; ++q) cv[q] = a.in[I_C][F.tid + q * (NWAVES * 64)];
#pragma unroll
      for (int q = 0; q < 32; ++q) csil[F.tid + q * (NWAVES * 64)] = cv[q] * sigmoidf_(cv[q]); }
    __syncthreads();
    { float* MODP = (float*)(ws + WS_MODP); const float* wm = a.in[I_WMOD];
      for (int task = gw; task < KC * 192; task += NGW) { const int kc = task / 192, ch = task % 192, n = ch * 64 + F.lane, kb = kc * (D / KC);
          float acc[NB];
#pragma unroll
          for (int b = 0; b < NB; ++b) acc[b] = 0.f;
#pragma unroll 64
          for (int k = 0; k < D / KC; ++k) { const float wv = wm[(size_t)(kb + k) * (6 * D) + n];
#pragma unroll
              for (int b = 0; b < NB; ++b) acc[b] = fmaf(csil[b * D + kb + k], wv, acc[b]); }
#pragma unroll
          for (int b = 0; b < NB; ++b) MODP[((size_t)kc * NB + b) * (6 * D) + n] = acc[b]; } }
    __syncthreads(); }
    LAS float* scr = (LAS float*)(F.lds + F.wave * 18432);
    constexpr int I_IN = 16 * (NIN_A / 32);
    constexpr int I_IN8 = 16 * (NIN_B / 32);
    constexpr int I_SQ = 16 * (D / 32);
    constexpr int I_UV = 16 * 4 * 4;
    constexpr int I_RT = 32;
    constexpr int NITEMS = I_IN + I_IN8 + 3 * I_SQ + I_UV;
    for (int it = gw; it < I_UV; it += NGW) { const int r = it;
        { const int h = r / 16, q = r % 16, kb = q / 4, nb = q % 4;
          transpose_item(a.in[I_WUV] + (size_t)h * 256 * 128, 128, (bf16*)(ws + WS_WKV) + (size_t)(2048 + h * 128) * 256, 256, 64 * kb, 32 * nb, scr, F.lane, [](int np) { return (np & 31) * 4 + (np >> 5); }, a.in[I_KVG]); }
    }
    __syncthreads();
    win_conv(F, a);
    __syncthreads();
    const int gt = F.vcu * (NWAVES * 64) + F.tid, NGT = F.G * NWAVES * 64;
    { bf16* wkv = (bf16*)(ws + WS_WKV); const float* wuk = a.in[I_WUK]; const float* kvg = a.in[I_KVG];
      for (int i = gt; i < 2048 * 256 / 2; i += NGT) { const int e0 = 2 * i, c = e0 & 255; ((unsigned*)wkv)[i] = cvtpk(wuk[e0] * kvg[c], wuk[e0 + 1] * kvg[c + 1]); } }
    { bf16* wsp = (bf16*)(ws + WS_WSP); const float* w = a.in[I_WSP];
      for (int i = gt; i < 8 * 128 * 128 / 2; i += NGT) { const int e0 = 2 * i, s = e0 & 127, t = (e0 >> 7) & 127;
          ((unsigned*)wsp)[i] = cvtpk(s <= t ? w[e0] : 0.f, (s + 1) <= t ? w[e0 + 1] : 0.f); } }
    { bf16* wrt = (bf16*)(ws + WS_WRT); const float* w = a.in[I_WR];
      for (int i = gt; i < NE * D; i += NGT) { const int e = i / D, k = i % D; const float v = w[(size_t)k * NE + e]; const unsigned h = cvtpk(v, 0.f) & 0xffffu; const float r = v - bf2f((unsigned short)h);
          wrt[i] = (bf16)h; wrt[NE * D + i] = (bf16)(cvtpk(r, 0.f) & 0xffffu); } }
}

template <bool LO>
__device__ __forceinline__ void norm_mod_rows_unit(const Frame& F, const Args& a, int unit, const float* X, const float* gain, int sc_off, int sh_off, bf16* H, bf16* HLO, const float* modf, unsigned char* H8 = nullptr) {
    const int b = unit / 32, row0 = unit * 64;
    LAS float* av = (LAS float*)F.lds; LAS float* sv = av + D;
    const float* MODP = (const float*)(a.ws + WS_MODP); const float* bm = a.in[I_BMOD];
    if (modf) { const float* mf = modf + (size_t)b * (6 * D); float gk[4], sk[4], hk[4];
#pragma unroll
        for (int q = 0; q < 4; ++q) { const int k = F.tid + q * (NWAVES * 64); gk[q] = gain[k]; sk[q] = mf[sc_off + k]; hk[q] = mf[sh_off + k]; }
#pragma unroll
        for (int q = 0; q < 4; ++q) { const int k = F.tid + q * (NWAVES * 64); av[k] = gk[q] * (1.0f + sk[q]); sv[k] = hk[q]; } }
    else {
#pragma unroll
        for (int k = F.tid; k < D; k += NWAVES * 64) { float sc = bm[sc_off + k], sh = bm[sh_off + k];
#pragma unroll
            for (int kc = 0; kc < KC; ++kc) { const float* p = MODP + ((size_t)kc * NB + b) * (6 * D); sc += p[sc_off + k]; sh += p[sh_off + k]; }
            av[k] = gain[k] * (1.0f + sc); sv[k] = sh; } }
    __syncthreads();
    for (int rr = F.wave * 2; rr < 64; rr += NWAVES * 2) {
        f32x4 v[2][8]; float s[2] = {0.f, 0.f};
#pragma unroll
        for (int q = 0; q < 2; ++q) { const f32x4* xr = (const f32x4*)(X + (size_t)(row0 + rr + q) * D) + F.lane;
#pragma unroll
            for (int j = 0; j < 8; ++j) v[q][j] = xr[64 * j]; }
#pragma unroll
        for (int q = 0; q < 2; ++q)
#pragma unroll
            for (int j = 0; j < 8; ++j) s[q] += (v[q][j][0] * v[q][j][0] + v[q][j][1] * v[q][j][1]) + (v[q][j][2] * v[q][j][2] + v[q][j][3] * v[q][j][3]);
#pragma unroll
        for (int q = 0; q < 2; ++q) { const int row = row0 + rr + q;
            const float rstd = 1.0f / sqrtf(wave_sum(s[q]) * (1.0f / D) + EPS);
            u32x2* o8 = (u32x2*)(H + (size_t)row * D) + F.lane; u32x2* l8 = (u32x2*)(HLO + (size_t)row * D) + F.lane;
#pragma unroll
            for (int j = 0; j < 8; ++j) { const f32x4 aa = ((const LAS f32x4*)av)[F.lane + 64 * j], ss = ((const LAS f32x4*)sv)[F.lane + 64 * j];
                const f32x4 y = (v[q][j] * rstd) * aa + ss; u32x2 w; w.x = cvtpk(y[0], y[1]); w.y = cvtpk(y[2], y[3]); if (H) o8[64 * j] = w;
                if (H8) ((unsigned*)(H8 + (size_t)row * D))[F.lane + 64 * j] = cvt4_fp8(y[0], y[1], y[2], y[3]);
                if (LO) { u32x2 l; l.x = cvtpk(y[0] - bflo(w.x), y[1] - bfhi(w.x)); l.y = cvtpk(y[2] - bflo(w.y), y[3] - bfhi(w.y)); l8[64 * j] = l; } } }
    }
    __syncthreads();
}

__device__ __forceinline__ void idx_scores_unit(const Frame& F, const Args& a, int b, int qt) {
    const bf16* QI = (const bf16*)(a.ws + WS_QI); const bf16* KI = (const bf16*)(a.ws + WS_KI); const float* WI = (const float*)(a.ws + WS_WI); float* SC = (float*)(a.ws + WS_SC);
    const int lane = F.lane, i = lane & 31, kg = lane >> 5;
    const int qbase = qt * 32 + 4 * F.wave;
    const int head = (i & 3) + 4 * (i >> 3), qsel = (i >> 2) & 1;
    bf16x8 af[2][8]; float w[2][16];
#pragma unroll
    for (int p = 0; p < 2; ++p) {
        const bf16* src = QI + (size_t)(b * SEQ + qbase + 2 * p + qsel) * D + head * 128 + kg * 8;
#pragma unroll
        for (int ks = 0; ks < 8; ++ks) af[p][ks] = *(const bf16x8*)(src + ks * 16);
        const float* wp = WI + (size_t)(b * SEQ + qbase + 2 * p + kg) * 16;
#pragma unroll
        for (int r4 = 0; r4 < 4; ++r4) { const f32x4 t = *(const f32x4*)(wp + 4 * r4); w[p][4 * r4] = t[0]; w[p][4 * r4 + 1] = t[1]; w[p][4 * r4 + 2] = t[2]; w[p][4 * r4 + 3] = t[3]; }
    }
    const int kend = 64 * ((qt * 32) / 64 + 1), ntile = kend / 32;
    constexpr int KPITCH = 272, KBUF = 32 * KPITCH;
    LAS char* kl = (LAS char*)F.lds;
    const bf16* kg_src = KI + (size_t)(b * SEQ + (F.tid >> 4)) * 128 + (F.tid & 15) * 8;
    const int kl_dst = (F.tid >> 4) * KPITCH + (F.tid & 15) * 16, kl_src = i * KPITCH + kg * 16;
    LAS float* swin = (LAS float*)(F.lds + 32768 + F.wave * 4096);
#pragma unroll
    for (int p = 0; p < 2; ++p) {
#pragma unroll
        for (int ks = 0; ks < 8; ++ks) asm volatile("" :: "v"(af[p][ks]));
#pragma unroll
        for (int r = 0; r < 16; ++r) asm volatile("" :: "v"(w[p][r])); }
    bf16x8 r0, r1;
#define IDX_GLOAD(dst, t_) asm volatile("global_load_dwordx4 %0, %1, off" : "=v"(dst) : "v"(kg_src + (size_t)((t_) * 32) * 128) : "memory")
    { const bf16x8 t0 = *(const bf16x8*)kg_src; *(LAS bf16x8*)(kl + kl_dst) = t0; }
    IDX_GLOAD(r0, 1);
    LDS_BARRIER();
#define IDX_STEP(t, RCUR, RNXT) do {                                                                                               \
        if ((t) + 2 < ntile) IDX_GLOAD(RNXT, (t) + 2);                                                                             \
        bf16x8 bfr[8];                                                                                                             \
        _Pragma("unroll") for (int ks = 0; ks < 8; ++ks) bfr[ks] = *(const LAS bf16x8*)(kl + ((t) & 1) * KBUF + kl_src + ks * 32);  \
        _Pragma("unroll") for (int p = 0; p < 2; ++p) { f32x16 acc = {};                                                           \
            _Pragma("unroll") for (int ks = 0; ks < 8; ++ks) acc = __builtin_amdgcn_mfma_f32_32x32x16_bf16(af[p][ks], bfr[ks], acc, 0, 0, 0); \
            float sc_ = 0.f;                                                                                                       \
            _Pragma("unroll") for (int r = 0; r < 16; ++r) sc_ = fmaf(fmaxf(acc[r], 0.f), w[p][r], sc_);                            \
            swin[(2 * p + kg) * 256 + ((t) & 7) * 32 + i] = sc_; }                 \
        if ((t) + 1 < ntile) { if ((t) + 2 < ntile) asm volatile("s_waitcnt vmcnt(1)" ::: "memory"); else asm volatile("s_waitcnt vmcnt(0)" ::: "memory"); \
            *(LAS bf16x8*)(kl + (((t) + 1) & 1) * KBUF + kl_dst) = RCUR; }                                                        \
        if (((t) & 7) == 7 || (t) == ntile - 1) {                                \
            const int w0 = ((t) & ~7) * 32; f32x4 fl[4];                                                                           \
            _Pragma("unroll") for (int q = 0; q < 4; ++q) fl[q] = *(const LAS f32x4*)(swin + q * 256 + 4 * lane);                  \
            _Pragma("unroll") for (int q = 0; q < 4; ++q) *(f32x4*)(SC + (size_t)(b * SEQ + qbase + q) * SEQ + w0 + 4 * lane) = fl[q]; } \
        LDS_BARRIER(); } while (0)
    for (int t = 0; t < ntile; t += 2) { IDX_STEP(t, r0, r1); IDX_STEP(t + 1, r1, r0); }
#undef IDX_STEP
#undef IDX_GLOAD
    VM_WAIT(); __syncthreads();
}

__device__ __forceinline__ void topk_mask_row(const Frame& F, const Args& a, int t) {
    const float* SC = (const float*)(a.ws + WS_SC) + (size_t)t * SEQ; unsigned* MK = (unsigned*)(a.ws + WS_MASK) + (size_t)t * 64;
    const int s = t & (SEQ - 1), nj = s / 64 + 1;
    if (nj * 64 <= KSEL) { MK[F.lane] = (F.lane * 32 < nj * 64) ? 0xffffffffu : 0u; return; }
    unsigned u[32];
    { float raw[32];
#pragma unroll
      for (int j = 0; j < 32; ++j) raw[j] = SC[(j < nj ? j : nj - 1) * 64 + F.lane];
#pragma unroll
      for (int j = 0; j < 32; ++j) { const unsigned bits = __float_as_uint(raw[j]); const unsigned key = bits ^ ((unsigned)((int)bits >> 31) | 0x80000000u); const unsigned keep = (unsigned)-(int)(j < nj); u[j] = key & keep; } }
    constexpr int LOWB = 18;
    unsigned prefix = 0u; int cntp = 0; bool done = false;
    for (int bit = 31; bit >= LOWB; --bit) { const unsigned cand = prefix | (1u << bit); int cnt = 0;
#pragma unroll
        for (int c8 = 0; c8 < 4; ++c8) if (nj > 8 * c8) {
#pragma unroll
            for (int j = 8 * c8; j < 8 * c8 + 8; ++j) cnt += __builtin_popcountll(__ballot(u[j] >= cand)); }
        if (cnt >= KSEL) { prefix = cand; cntp = cnt; if (cnt == KSEL) { done = true; break; } } }
    if (!done) {
        if (cntp == 0) { cntp = 0;
#pragma unroll
            for (int j = 0; j < 32; ++j) cntp += __builtin_popcountll(__ballot(u[j] >= 1u)); }
        const unsigned hic = prefix + (1u << LOWB); int cnt_hi = 0;
        if (hic > prefix) {
#pragma unroll
            for (int c8 = 0; c8 < 4; ++c8) if (nj > 8 * c8) {
#pragma unroll
                for (int j = 8 * c8; j < 8 * c8 + 8; ++j) cnt_hi += __builtin_popcountll(__ballot(u[j] >= hic)); } }
        const int namb = cntp - cnt_hi;
        if (namb <= 128) {
            LAS unsigned* cb = (LAS unsigned*)(F.lds + 98304 + F.wave * 512); int base = 0;
#pragma unroll
            for (int j = 0; j < 32; ++j) { const bool amb = (u[j] - prefix) < (1u << LOWB) && u[j] >= prefix; const unsigned long long mk = __ballot(amb);
                const int pos = base + (int)__builtin_amdgcn_mbcnt_hi((unsigned)(mk >> 32), __builtin_amdgcn_mbcnt_lo((unsigned)mk, 0u));
                if (amb) cb[pos] = u[j];
                base += __builtin_popcountll(mk); }
            const unsigned c0 = F.lane < namb ? cb[F.lane] : 0u, c1 = F.lane + 64 < namb ? cb[F.lane + 64] : 0u;
            for (int bit = LOWB - 1; bit >= 0; --bit) { const unsigned cand = prefix | (1u << bit);
                const int cnt = cnt_hi + __builtin_popcountll(__ballot(c0 >= cand)) + __builtin_popcountll(__ballot(c1 >= cand));
                if (cnt >= KSEL) { prefix = cand; if (cnt == KSEL) break; } }
        } else {
            for (int bit = LOWB - 1; bit >= 0; --bit) { const unsigned cand = prefix | (1u << bit); int cnt = 0;
#pragma unroll
                for (int c8 = 0; c8 < 4; ++c8) if (nj > 8 * c8) {
#pragma unroll
                    for (int j = 8 * c8; j < 8 * c8 + 8; ++j) cnt += __builtin_popcountll(__ballot(u[j] >= cand)); }
                if (cnt >= KSEL) { prefix = cand; if (cnt == KSEL) break; } } }
    }
    unsigned wx = 0u, wy = 0u;
#pragma unroll
    for (int j = 0; j < 32; ++j) { const unsigned long long bal = __ballot(u[j] >= prefix);
        const unsigned blo = __builtin_amdgcn_readfirstlane((unsigned)bal), bhi = __builtin_amdgcn_readfirstlane((unsigned)(bal >> 32));
        asm volatile("s_nop 4\n\tv_writelane_b32 %0, %2, %4\n\tv_writelane_b32 %1, %3, %4" : "+v"(wx), "+v"(wy) : "s"(blo), "s"(bhi), "n"(j)); }
    if (F.lane < 32) { u32x2 w; w.x = wx; w.y = wy; *(u32x2*)(MK + 2 * F.lane) = w; }
}

__device__ __forceinline__ void spatial_group(const Frame& F, const Args& a, int b, int n, int gh) {
    using namespace att;
    const bf16* V = (const bf16*)(a.ws + WS_V); const bf16* U = (const bf16*)(a.ws + WS_U); unsigned char* SG8 = (unsigned char*)(a.ws + WS_SG);
    char* lds = (char*)F.lds;
    const int tid = F.tid, lane = F.lane, r32 = lane & 31, hi = lane >> 5, tt = F.wave & 3, dh = F.wave >> 2;
    const int tok0 = b * SEQ + n * 128, sr = tid >> 4, sc = (tid & 15) * 8;
    LAS f32x2* stat = (LAS f32x2*)(lds + 4 * SHM_V);
    { const int row = tid >> 2, q = tid & 3; const f32x4* p = (const f32x4*)((const float*)(a.ws + WS_VST) + ((size_t)(tok0 + row) * 32 + q * 8) * 2);
      const f32x4 p0 = p[0], p1 = p[1], p2 = p[2], p3 = p[3];
      float s1 = (p0[0] + p0[2]) + (p1[0] + p1[2]) + (p2[0] + p2[2]) + (p3[0] + p3[2]), s2 = (p0[1] + p0[3]) + (p1[1] + p1[3]) + (p2[1] + p2[3]) + (p3[1] + p3[3]);
      s1 += __shfl_xor(s1, 1); s1 += __shfl_xor(s1, 2); s2 += __shfl_xor(s2, 1); s2 += __shfl_xor(s2, 2);
      const float mean = s1 * (1.0f / D), var = fmaxf(s2 * (1.0f / D) - mean * mean, 0.f);
      if (q == 0) stat[row] = (f32x2){mean, 1.0f / sqrtf(var + EPS)}; }
    bf16x8 xr[4][2]; f32x4 gn[2][2];
#define SP_LOAD(g_) do { _Pragma("unroll") for (int tl = 0; tl < 4; ++tl) { const int dhh = tl >> 1, kh = tl & 1; const bf16* src = V + (size_t)(tok0 + 64 * kh) * D + (g_) * 256 + 128 * dhh + sc; \
          xr[tl][0] = *(const bf16x8*)(src + (size_t)sr * D); xr[tl][1] = *(const bf16x8*)(src + (size_t)(32 + sr) * D); } \
      _Pragma("unroll") for (int dhh = 0; dhh < 2; ++dhh) { const float* gp = a.in[I_SGG] + (g_) * 256 + 128 * dhh + sc; gn[dhh][0] = *(const f32x4*)gp; gn[dhh][1] = *(const f32x4*)(gp + 4); } } while (0)
    SP_LOAD(4 * gh);
    const int vb0 = (int)(uintptr_t)lds + v_rd_base(lane);
#pragma unroll 1
    for (int i = 0; i < 4; ++i) { const int g = 4 * gh + i;
        const bf16* WSP = (const bf16*)(a.ws + WS_WSP) + (size_t)g * 128 * 128; const float* bsp = a.in[I_BSP] + g * 128;
        bf16x8 pa[8];
        { const bf16* wp = WSP + (size_t)(32 * tt + r32) * 128 + 8 * hi;
#pragma unroll
          for (int ks = 0; ks < 8; ++ks) pa[ks] = *(const bf16x8*)(wp + 16 * ks); }
        LDS_BARRIER();
#pragma unroll
        for (int tl = 0; tl < 4; ++tl) { const int dhh = tl >> 1, kh = tl & 1;
#pragma unroll
            for (int h2 = 0; h2 < 2; ++h2) { const int rl = 64 * kh + 32 * h2 + sr; const f32x2 ms = stat[rl]; f32x4 x0, x1; pg8::unpack8(__builtin_bit_cast(u32x4, xr[tl][h2]), x0, x1);
                const f32x4 y0 = (x0 - ms.x) * ms.y * gn[dhh][0], y1 = (x1 - ms.x) * ms.y * gn[dhh][1];
#pragma unroll
                for (int d0 = 0; d0 < 4; ++d0) *(unsigned*)(lds + tl * SHM_V + v_st(32 * h2 + sr, d0 * 32 + (sc >> 2))) = cvtpk(y0[d0], y1[d0]); } }
        if (i < 3) SP_LOAD(g + 1);
        LDS_BARRIER();
        f32x16 o[4] = {};
        if (dh == 0) { pv_tile<0>(o, vb0, pa[0], pa[1], pa[2], pa[3]); pv_tile<1>(o, vb0, pa[4], pa[5], pa[6], pa[7]); }
        else         { pv_tile<2>(o, vb0, pa[0], pa[1], pa[2], pa[3]); pv_tile<3>(o, vb0, pa[4], pa[5], pa[6], pa[7]); }
        float bb[16]; u32x2 uu[16];
#pragma unroll
        for (int r = 0; r < 16; ++r) { const int tl = 32 * tt + crow(r, hi); bb[r] = bsp[tl]; uu[r] = *(const u32x2*)(U + (size_t)(tok0 + tl) * D + g * 256 + dh * 128 + 4 * r32); }
#pragma unroll
        for (int r = 0; r < 16; ++r) { const int tl = 32 * tt + crow(r, hi); const size_t rowoff = (size_t)(tok0 + tl) * D + g * 256 + dh * 128 + 4 * r32;
            *(unsigned*)(SG8 + rowoff) = cvt4_fp8((o[0][r] + bb[r]) * bflo(uu[r].x), (o[1][r] + bb[r]) * bfhi(uu[r].x), (o[2][r] + bb[r]) * bflo(uu[r].y), (o[3][r] + bb[r]) * bfhi(uu[r].y)); }
    }
#undef SP_LOAD
    __syncthreads();
}

__device__ __forceinline__ att::BlockRef attn_ref(const Args& a, int item, int pass) {
    const int bh = item >> 2, x = item & 3, b = bh >> 4, h = bh & 15, qb = pass ? 7 - x : x;
    att::BlockRef r; const size_t base = (size_t)(b * SEQ) * D + h * 128;
    r.Q = (const bf16*)(a.ws + WS_Q) + base + (size_t)(qb * 256) * D; r.O = (bf16*)((unsigned char*)(a.ws + WS_OA) + base + (size_t)(qb * 256) * D);
    r.K = (const bf16*)(a.ws + WS_KH) + base; r.V = (const bf16*)(a.ws + WS_VH) + base;
    r.M = (const unsigned*)(a.ws + WS_MASK) + (size_t)(b * SEQ + qb * 256) * 64; r.P0 = qb * 256;
    return r;
}
__device__ __forceinline__ void attn_phase(const Frame& F, const Args& a) {
    constexpr int NITEMS = NB * 16 * 4;
    int L = F.vcu; if (L >= NITEMS) return;
    int pass = 0; att::BlockRef cur = attn_ref(a, L, 0); att::Seam S;
    att::attn_prime(cur, (char*)F.lds, S);
    for (;;) {
        const bool more_pass = pass == 0, more_item = L + F.G < NITEMS, last = !more_pass && !more_item;
        int Ln = L, passn = pass + 1; if (!more_pass) { passn = 0; Ln = more_item ? L + F.G : L; }
        const att::BlockRef nxt = last ? cur : attn_ref(a, Ln, passn);
        att::attn_block(cur, nxt, (char*)F.lds, S);
        if (last) break;
        cur = nxt; L = Ln; pass = passn;
    }
    VM_WAIT(); __syncthreads();
}

__device__ __forceinline__ void router_unit(const Frame& F, const Args& a, int unit) {
    const int b = unit / 32, row0 = unit * 64, lane = F.lane, wave = F.wave, r32 = lane & 31, hi = lane >> 5, l16 = lane & 15, kg = lane >> 4;
    constexpr int RP = 4112;
    LAS char* hiL = (LAS char*)F.lds; LAS char* loL = hiL + 16 * RP;
    LAS float* part = (LAS float*)F.lds;
    LAS float* logit = (LAS float*)(F.lds + 2 * 16 * RP);
    LAS int* hist = (LAS int*)(F.lds + 2 * 16 * RP + 2048);
    const float* X1 = (const float*)(a.ws + WS_X1); unsigned char* H8 = (unsigned char*)(a.ws + WS_H2F8);
    const bf16* WH = (const bf16*)(a.ws + WS_WRT); const bf16* WL = WH + NE * D;
    f32x4 av[8], sv[8];
    { const float* mf = (const float*)(a.ws + WS_MODF) + (size_t)b * (6 * D); const float* gn = a.in[I_N2G];
#pragma unroll
      for (int j = 0; j < 8; ++j) { const int k = 4 * (lane + 64 * j); const f32x4 g4 = *(const f32x4*)(gn + k), sc = *(const f32x4*)(mf + 4 * D + k); sv[j] = *(const f32x4*)(mf + 3 * D + k); av[j] = g4 * (sc + 1.0f); } }
    const float br = a.in[I_BR][F.tid & 31];
    if (F.tid < NE) hist[F.tid] = 0;
#pragma unroll 1
    for (int grp = 0; grp < 4; ++grp) {
        { f32x4 v[2][8]; float ss[2] = {0.f, 0.f};
#pragma unroll
          for (int q = 0; q < 2; ++q) { const f32x4* xr = (const f32x4*)(X1 + (size_t)(row0 + 16 * grp + 2 * wave + q) * D) + lane;
#pragma unroll
              for (int j = 0; j < 8; ++j) v[q][j] = xr[64 * j]; }
#pragma unroll
          for (int q = 0; q < 2; ++q)
#pragma unroll
              for (int j = 0; j < 8; ++j) ss[q] += (v[q][j][0] * v[q][j][0] + v[q][j][1] * v[q][j][1]) + (v[q][j][2] * v[q][j][2] + v[q][j][3] * v[q][j][3]);
#pragma unroll
          for (int q = 0; q < 2; ++q) { const int rl = 2 * wave + q; const size_t row = (size_t)(row0 + 16 * grp + rl);
              const float rstd = 1.0f / sqrtf(wave_sum(ss[q]) * (1.0f / D) + EPS);
#pragma unroll
              for (int j = 0; j < 8; ++j) { const f32x4 y = (v[q][j] * rstd) * av[j] + sv[j];
                  ((unsigned*)(H8 + row * D))[lane + 64 * j] = cvt4_fp8(y[0], y[1], y[2], y[3]);
                  u32x2 w; w.x = cvtpk(y[0], y[1]); w.y = cvtpk(y[2], y[3]);
                  u32x2 l; l.x = cvtpk(y[0] - bflo(w.x), y[1] - bfhi(w.x)); l.y = cvtpk(y[2] - bflo(w.y), y[3] - bfhi(w.y));
                  *(LAS u32x2*)(hiL + rl * RP + (lane + 64 * j) * 8) = w; *(LAS u32x2*)(loL + rl * RP + (lane + 64 * j) * 8) = l; } } }
        LDS_BARRIER();
        f32x4 acc[2] = {{0.f, 0.f, 0.f, 0.f}, {0.f, 0.f, 0.f, 0.f}};
#pragma unroll 1
        for (int kb = 0; kb < 2; ++kb) { bf16x8 bh[4][2], bl[4][2];
#pragma unroll
            for (int ks = 0; ks < 4; ++ks)
#pragma unroll
                for (int nt = 0; nt < 2; ++nt) { const size_t o = (size_t)(l16 + 16 * nt) * D + 256 * wave + 32 * (4 * kb + ks) + 8 * kg; bh[ks][nt] = *(const bf16x8*)(WH + o); bl[ks][nt] = *(const bf16x8*)(WL + o); }
#pragma unroll
            for (int ks = 0; ks < 4; ++ks) { const int ko = (256 * wave + 32 * (4 * kb + ks) + 8 * kg) * 2;
                const bf16x8 ah = *(const LAS bf16x8*)(hiL + l16 * RP + ko), al = *(const LAS bf16x8*)(loL + l16 * RP + ko);
#pragma unroll
                for (int nt = 0; nt < 2; ++nt) { acc[nt] = __builtin_amdgcn_mfma_f32_16x16x32_bf16(ah, bh[ks][nt], acc[nt], 0, 0, 0);
                    acc[nt] = __builtin_amdgcn_mfma_f32_16x16x32_bf16(ah, bl[ks][nt], acc[nt], 0, 0, 0);
                    acc[nt] = __builtin_amdgcn_mfma_f32_16x16x32_bf16(al, bh[ks][nt], acc[nt], 0, 0, 0); } } }
        LDS_BARRIER();
#pragma unroll
        for (int nt = 0; nt < 2; ++nt)
#pragma unroll
            for (int j = 0; j < 4; ++j) part[(wave * 16 + 4 * kg + j) * 32 + 16 * nt + l16] = acc[nt][j];
        LDS_BARRIER();
        { const int rr = F.tid >> 5, e = F.tid & 31; float sum = br;
#pragma unroll
          for (int wv = 0; wv < 8; ++wv) sum += part[(wv * 16 + rr) * 32 + e];
          logit[rr * 32 + e] = sum; }
        LDS_BARRIER();
        { const int rl = 2 * wave + hi, t = row0 + 16 * grp + rl; float v = logit[rl * 32 + r32]; int ei[4]; float ev[4];
#pragma unroll
          for (int k = 0; k < 4; ++k) { float m = v;
#pragma unroll
              for (int o = 1; o < 32; o <<= 1) m = fmaxf(m, __shfl_xor(m, o));
              const unsigned long long bal = __ballot(v == m); const unsigned mine = hi ? (unsigned)(bal >> 32) : (unsigned)bal; const int bi = __ffs(mine) - 1;
              ei[k] = bi; ev[k] = m; if (r32 == bi) v = -__builtin_inff(); }
          if (r32 == 0) { float ex[4], sum = 0.f;
#pragma unroll
              for (int k = 0; k < 4; ++k) { ex[k] = __expf(ev[k] - ev[0]); sum += ex[k]; }
              int* TE = (int*)(a.ws + WS_ROUTE + RT_TOPE) + (size_t)t * 4; float* TG = (float*)(a.ws + WS_ROUTE + RT_TOPG) + (size_t)t * 4; const float inv = 1.0f / sum;
              *(int4*)TE = make_int4(ei[0], ei[1], ei[2], ei[3]); *(f32x4*)TG = (f32x4){ex[0] * inv, ex[1] * inv, ex[2] * inv, ex[3] * inv};
#pragma unroll
              for (int k = 0; k < 4; ++k) atomicAdd((int*)&hist[ei[k]], 1); } }
    }
    __syncthreads();
    if (F.tid < NE) ((int*)(a.ws + WS_ROUTE + RT_HIST))[unit * NE + F.tid] = hist[F.tid];
    __syncthreads();
}

__device__ __forceinline__ void route_unit(const Frame& F, const Args& a, int unit) {
    const int* HIST = (const int*)(a.ws + WS_ROUTE + RT_HIST); const int* TE = (const int*)(a.ws + WS_ROUTE + RT_TOPE) + (size_t)unit * 256; const float* TG = (const float*)(a.ws + WS_ROUTE + RT_TOPG) + (size_t)unit * 256;
    int* POS = (int*)(a.ws + WS_ROUTE + RT_POS) + (size_t)unit * 256; float* RG = (float*)(a.ws + WS_ROUTE + RT_GATE);
    LAS int* cnt = (LAS int*)F.lds; LAS int* before = cnt + 32; LAS int* pstart = cnt + 64; LAS int* te = cnt + 128; LAS int* posl = cnt + 384;
    { LAS int* hl = cnt + 1024;
      { int hv[16];
#pragma unroll
        for (int q = 0; q < 16; ++q) hv[q] = HIST[F.tid + q * (NWAVES * 64)];
#pragma unroll
        for (int q = 0; q < 16; ++q) hl[F.tid + q * (NWAVES * 64)] = hv[q]; }
      __syncthreads();
      if (F.tid < NE) { int c = 0, bf = 0; for (int u2 = 0; u2 < T / 64; ++u2) { const int h = hl[u2 * NE + F.tid]; c += h; if (u2 < unit) bf += h; } cnt[F.tid] = c; before[F.tid] = bf; } }
    if (F.tid < 256) te[F.tid] = TE[F.tid];
    __syncthreads();
    if (F.tid == 0) { int run = 0; for (int e = 0; e < NE; ++e) { pstart[e] = run; run += ((cnt[e] + 255) >> 8) << 8; }
        if (unit == 0) { int* TILE = (int*)(a.ws + WS_ROUTE + RT_TILE); int mt = 0; for (int e = 0; e < NE; ++e) { const int ntile = (cnt[e] + 255) >> 8; for (int q = 0; q < ntile; ++q) TILE[mt++] = e; }
            *(int*)(a.ws + WS_ROUTE + RT_NMT) = mt; } }
    __syncthreads();
    if (F.tid < NE) { int run = pstart[F.tid] + before[F.tid]; for (int sl = 0; sl < 256; ++sl) if (te[sl] == F.tid) posl[sl] = run++; }
    __syncthreads();
    if (F.tid < 256) { const int p = posl[F.tid]; POS[F.tid] = p; RG[p] = TG[F.tid]; ((int*)(a.ws + WS_ROUTE + RT_TOK))[p] = unit * 64 + (F.tid >> 2); }
    __syncthreads();
}

template <bool MOE>
__device__ __forceinline__ void final_rows(const Frame& F, const Args& a, int gw, int NGW) {
    const float* X1 = (const float*)(a.ws + WS_X1); const int* POS = (const int*)(a.ws + WS_ROUTE + RT_POS); const bf16* YS = (const bf16*)(a.ws + WS_YS);
    f32x4 fg[8];
#pragma unroll
    for (int j = 0; j < 8; ++j) fg[j] = ((const f32x4*)a.in[I_FG])[F.lane + 64 * j];
    int row = gw; if (row >= T) return;
    f32x4 v[8]; int4 pos = make_int4(0, 0, 0, 0);
#pragma unroll
    for (int j = 0; j < 8; ++j) v[j] = ((const f32x4*)(X1 + (size_t)row * D))[F.lane + 64 * j];
    if (MOE) pos = *(const int4*)(POS + (size_t)row * 4);
    for (; row < T; row += NGW) {
        f32x4 m[8];
#pragma unroll
        for (int j = 0; j < 8; ++j) m[j] = (f32x4){0.f, 0.f, 0.f, 0.f};
        f32x4 g2[8];
        if (MOE) {
            const int pk[4] = {__builtin_amdgcn_readfirstlane(pos.x), __builtin_amdgcn_readfirstlane(pos.y), __builtin_amdgcn_readfirstlane(pos.z), __builtin_amdgcn_readfirstlane(pos.w)};
            u32x2 ys[4][8];
#pragma unroll
            for (int k = 0; k < 4; ++k)
#pragma unroll
                for (int j = 0; j < 8; ++j) ys[k][j] = ((const u32x2*)(YS + (size_t)pk[k] * D))[F.lane + 64 * j];
#pragma unroll
            for (int j = 0; j < 8; ++j) g2[j] = ((const f32x4*)((const float*)(a.ws + WS_MODF) + (size_t)(row / SEQ) * (6 * D) + 5 * D))[F.lane + 64 * j];
#pragma unroll
            for (int k = 0; k < 4; ++k)
#pragma unroll
                for (int j = 0; j < 8; ++j) { const u32x2 w = ys[k][j]; m[j] += (f32x4){bflo(w.x), bfhi(w.x), bflo(w.y), bfhi(w.y)}; }
        }
        const int nrow = row + NGW; f32x4 vn[8]; int4 posn = pos;
        if (nrow < T) {
#pragma unroll
            for (int j = 0; j < 8; ++j) vn[j] = ((const f32x4*)(X1 + (size_t)nrow * D))[F.lane + 64 * j];
            if (MOE) posn = *(const int4*)(POS + (size_t)nrow * 4); }
        if (MOE) {
#pragma unroll
            for (int j = 0; j < 8; ++j) v[j] += g2[j] * m[j]; }
        float ss = 0.f;
#pragma unroll
        for (int j = 0; j < 8; ++j) ss += (v[j][0] * v[j][0] + v[j][1] * v[j][1]) + (v[j][2] * v[j][2] + v[j][3] * v[j][3]);
        const float rstd = 1.0f / sqrtf(wave_sum(ss) * (1.0f / D) + EPS);
        f32x4* o = (f32x4*)(a.out + (size_t)row * D) + F.lane;
#pragma unroll
        for (int j = 0; j < 8; ++j) o[64 * j] = v[j] * rstd * fg[j];
        if (nrow < T) {
#pragma unroll
            for (int j = 0; j < 8; ++j) v[j] = vn[j];
            pos = posn; }
    }
}

constexpr int N_PHASES = 13;
constexpr int N_LAUNCHES = MK_N_LAUNCHES;

__global__ void __launch_bounds__(NWAVES * 64, 2) fwd_kernel(Args args) {
    extern __shared__ __attribute__((aligned(16))) unsigned char lds_raw[];
    Frame F;
    F.lds = (LAS unsigned char*)lds_raw;
    F.tid = threadIdx.x; F.lane = F.tid & 63; F.wave = __builtin_amdgcn_readfirstlane(F.tid >> 6);
    F.G = gridDim.x; { const int bx = blockIdx.x; F.vcu = (F.G % 8 == 0) ? (bx % 8) * (F.G / 8) + bx / 8 : bx; }
    volatile LAS unsigned* MISC = (volatile LAS unsigned*)(F.lds + MISC_OFF);
    for (int u = F.tid; u < (LDS_BYTES - LDSCTL_OFF) / 4; u += NWAVES * 64) ((LAS unsigned*)(F.lds + LDSCTL_OFF))[u] = 0u;
    __syncthreads();
    unsigned char* ws = args.ws;
    unsigned* barw = (unsigned*)(ws + WS_CTL) + CW_BAR;
    XcdBarrier bar; bar.bar = barw; bar.x = 0; bar.st = nullptr;
    if (N_LAUNCHES == 1) bar = xcd_barrier_post(barw, MISC + 8);
    const int lo = args.ph_lo, hi = args.ph_hi;
#ifndef PH_MASK
#define PH_MASK 0xffff
#endif
#define IN(k) (((PH_MASK >> (k)) & 1) && lo <= (k) && (k) < hi)
#define SEAM(k) do { if (IN(k) && IN((k) + 1)) xcd_barrier(bar); } while (0)
    const int gw = F.vcu * NWAVES + F.wave, NGW = F.G * NWAVES;
    const int NUNIT64 = T / 64;

    if (IN(0)) { p0_prologue(F, args); }

    SEAM(0);
    if (IN(1)) {
        for (int u = F.vcu; u < NUNIT64; u += F.G) norm_mod_rows_unit<false>(F, args, u, args.in[I_X], args.in[I_N1G], 1 * D, 0 * D, nullptr, nullptr, nullptr, (unsigned char*)(ws + WS_H1F8));
        { const float* MODP = (const float*)(ws + WS_MODP); float* MODF = (float*)(ws + WS_MODF); const float* bm = args.in[I_BMOD];
          for (int i = F.vcu * (NWAVES * 64) + F.tid; i < NB * 6 * D; i += F.G * NWAVES * 64) { const int b = i / (6 * D), n = i % (6 * D); float s = bm[n];
#pragma unroll
              for (int kc = 0; kc < KC; ++kc) s += MODP[((size_t)kc * NB + b) * (6 * D) + n];
              MODF[i] = s; } }
    }

    SEAM(1);
    if (IN(2)) {
        { pg8::Gemm g{(const bf16*)(ws + WS_H1F8), (const bf16*)(ws + WS_WIN8), D}; pg8::UnevenOrder S; S.init(T, NIN_B, F.G, (int)blockIdx.x);
          pg8::EpiG1b E{ws};
          pg8::gemm_phase<pg8::EpiG1b, pg8::UnevenOrder, true>(F.lds, g, S, E); }
        pg8::Gemm g{(const bf16*)(ws + WS_H1F8), (const bf16*)(ws + WS_WIN), D}; pg8::StaticOrder S; S.init(T, NIN_A, F.G, (int)blockIdx.x);
        pg8::EpiG1 E{(bf16*)(ws + WS_QI), (bf16*)(ws + WS_KI), (float*)(ws + WS_WI)};
        pg8::gemm_phase<pg8::EpiG1, pg8::StaticOrder, true>(F.lds, g, S, E);
    }

    SEAM(2);
    if (IN(3)) {
        { pg8::Gemm g{(const bf16*)(ws + WS_CKV), (const bf16*)(ws + WS_WKV), 256}; pg8::StaticOrder S; S.init(T, 4096, F.G, (int)blockIdx.x);
          pg8::EpiKV E{(bf16*)(ws + WS_KH), (bf16*)(ws + WS_VH), (const float*)(ws + WS_SSQ)};
          pg8::gemm_phase<pg8::EpiKV, pg8::StaticOrder>(F.lds, g, S, E); }

        for (int it = F.vcu; it < 256; it += F.G) { const int b = it >> 5, x = it & 31;
#pragma unroll 1
            for (int pass = 0; pass < 2; ++pass) { const int qt = pass ? 63 - x : x;
                idx_scores_unit(F, args, b, qt);
                for (int q = 0; q < 4; ++q) topk_mask_row(F, args, b * SEQ + qt * 32 + 4 * F.wave + q);
                } }

        for (int u = F.vcu; u < NB * 16 * 2; u += F.G) spatial_group(F, args, u >> 5, (u >> 1) & 15, u & 1);

    }
    SEAM(4);
    if (IN(5)) {
        const bool conv_first = (blockIdx.x & 1) == 0;
        if (conv_first) moe_conv(F, args);
#ifndef NO_ATTN
        attn_phase(F, args);
#endif

#ifndef NO_YB
        { pg8::Gemm g{(const bf16*)(ws + WS_SG), (const bf16*)(ws + WS_WPB), D}; pg8::StaticOrder S; S.init(T, D, F.G, (int)blockIdx.x);
          pg8::EpiGate<false> E{(const bf16*)(ws + WS_GB), nullptr, (void*)(ws + WS_YB)};
          pg8::gemm_phase<pg8::EpiGate<false>, pg8::StaticOrder, true>(F.lds, g, S, E); }
#endif
        if (!conv_first) { __syncthreads(); moe_conv(F, args); }

    }
    SEAM(5);
    if (IN(6)) {
        pg8::Gemm g{(const bf16*)(ws + WS_OA), (const bf16*)(ws + WS_WPA), D}; pg8::StaticOrder S; S.init(T, D, F.G, (int)blockIdx.x);
        pg8::EpiGate<true> E{(const bf16*)(ws + WS_GA), (const bf16*)(ws + WS_YB), (void*)(ws + WS_MIX)};
        pg8::gemm_phase<pg8::EpiGate<true>, pg8::StaticOrder, true>(F.lds, g, S, E);
    }

    SEAM(6);
    if (IN(7)) {
        pg8::Gemm g{(const bf16*)(ws + WS_MIX), (const bf16*)(ws + WS_WOUT), D}; pg8::StaticOrder S; S.init(T, D, F.G, (int)blockIdx.x);
        pg8::EpiX1 E{args.in[I_X], (const float*)(ws + WS_MODF), (float*)(ws + WS_X1)};
        pg8::gemm_phase<pg8::EpiX1, pg8::StaticOrder, true>(F.lds, g, S, E);
    }

    SEAM(7);
    if (IN(8)) { { int* rt = (int*)(ws + WS_ROUTE + RT_TOK); for (int i = F.vcu * (NWAVES * 64) + F.tid; i < PMAX; i += F.G * NWAVES * 64) rt[i] = 0; }
        for (int u = F.vcu; u < NUNIT64; u += F.G) router_unit(F, args, u); }

    SEAM(8);
    if (IN(9)) { for (int u = F.vcu; u < NUNIT64; u += F.G) route_unit(F, args, u); }

    SEAM(9);
    if (IN(10)) {
        const int nmt = __builtin_amdgcn_readfirstlane(*(const int*)(ws + WS_ROUTE + RT_NMT));
        LAS int* tile_lds = (LAS int*)(F.lds + LDSCTL_OFF + 1024);
        if (F.tid < MT_MAX) tile_lds[F.tid] = ((const int*)(ws + WS_ROUTE + RT_TILE))[F.tid < nmt ? F.tid : 0];
        __syncthreads();
        pg8::Gemm g{(const bf16*)(ws + WS_H2F8), (const bf16*)(ws + WS_WGU), D}; pg8::MoeGatherOrder S; S.init(nmt, 16, F.G, (int)blockIdx.x, tile_lds); S.rowtok = (const int*)(ws + WS_ROUTE + RT_TOK);
        pg8::EpiUp E{args.in[I_BGU], (unsigned char*)(ws + WS_ACT)};
        pg8::gemm_phase<pg8::EpiUp, pg8::MoeGatherOrder, true>(F.lds, g, S, E);
    }

    SEAM(10);
    if (IN(11)) {
        const int nmt = __builtin_amdgcn_readfirstlane(*(const int*)(ws + WS_ROUTE + RT_NMT));
        LAS int* tile_lds = (LAS int*)(F.lds + LDSCTL_OFF + 1024);
        if (F.tid < MT_MAX) tile_lds[F.tid] = ((const int*)(ws + WS_ROUTE + RT_TILE))[F.tid < nmt ? F.tid : 0];
        __syncthreads();
        pg8::Gemm g{(const bf16*)(ws + WS_ACT), (const bf16*)(ws + WS_WD), DFF}; pg8::MoeOrder S; S.init(nmt, 8, F.G, (int)blockIdx.x, tile_lds);
        pg8::EpiDown E{args.in[I_BD], (const float*)(ws + WS_ROUTE + RT_GATE), (bf16*)(ws + WS_YS)};
        pg8::gemm_phase<pg8::EpiDown, pg8::MoeOrder, true>(F.lds, g, S, E);
    }

    SEAM(11);
    if (IN(12)) { final_rows<(MK_STAGE >= 9)>(F, args, gw, NGW); }

#undef IN
#undef SEAM
}

extern "C" void kernel_launch(void* const* d_in, const int* in_sizes, int n_in, void* d_out, int out_size, void* d_ws, size_t ws_size, hipStream_t stream) {
    static int grid = 0;
    if (grid == 0) {
        if (n_in != 23 || out_size != T * D || ws_size < WS_END) { fprintf(stderr, "kernel_launch: unexpected shapes (n_in %d, out %d, ws %zu < %zu)\n", n_in, out_size, ws_size, (size_t)WS_END); grid = -1; return; }
        int dev = 0, cus = 0, per_cu = 0;
        if (hipGetDevice(&dev) != hipSuccess || hipDeviceGetAttribute(&cus, hipDeviceAttributeMultiprocessorCount, dev) != hipSuccess) { grid = -1; return; }
        if (hipFuncSetAttribute((const void*)fwd_kernel, hipFuncAttributeMaxDynamicSharedMemorySize, LDS_BYTES) != hipSuccess) { fprintf(stderr, "kernel_launch: hipFuncSetAttribute failed\n"); grid = -1; return; }
        if (hipOccupancyMaxActiveBlocksPerMultiprocessor(&per_cu, (const void*)fwd_kernel, NWAVES * 64, LDS_BYTES) != hipSuccess || per_cu < 1) { fprintf(stderr, "kernel_launch: occupancy query says %d\n", per_cu); }
        (void)hipGetLastError();
        grid = cus;
    }
    if (grid < 0) return;
    (void)hipMemsetAsync((char*)d_ws + WS_CTL, 0, CTL_ZERO_BYTES, stream);
    Args a{};
    for (int i = 0; i < 23; ++i) a.in[i] = (const float*)d_in[i];
    a.out = (float*)d_out; a.ws = (unsigned char*)d_ws;
    if (N_LAUNCHES == 1) { a.ph_lo = 0; a.ph_hi = N_PHASES; hipLaunchKernelGGL(fwd_kernel, dim3(grid), dim3(NWAVES * 64), LDS_BYTES, stream, a); }
    else { for (int p = 0; p < N_PHASES; ++p) {
#if MK_STAGE < 9
        if (p >= 8 && p < 12) continue;
#endif
        a.ph_lo = p; a.ph_hi = p + 1; hipLaunchKernelGGL(fwd_kernel, dim3(grid), dim3(NWAVES * 64), LDS_BYTES, stream, a); } }
}
```
